# Optimizing an MI355X kernel written in HIP

```python
import jax, jax.numpy as jnp
from jax import lax
import numpy as np

D_MODEL = 2048
BATCH = 2
SEQ = 16384
DEPTH = 2

N_META = 16
GRID_W = 64
EPS = 1e-6
NA_HEADS = 8
NA_DIM = 128
NA_WIDTH = NA_HEADS * NA_DIM
WIN_H = 8
WIN_W = 16
NA_QB = 16
NA_KSPAN = NA_QB + WIN_W
ML_HEADS = 4
ML_QK = 128
ML_V = 256
ML_QK_WIDTH = ML_HEADS * ML_QK
ML_WIDTH = ML_HEADS * ML_V
ML_CHUNK = 64
MIX_WIDTH = NA_WIDTH + ML_WIDTH
EVEN_SIZES = (NA_WIDTH, NA_WIDTH, NA_WIDTH, ML_QK_WIDTH, ML_QK_WIDTH, ML_WIDTH, ML_WIDTH, 4 * ML_HEADS)
EVEN_IN = 3 * NA_WIDTH + 2 * ML_QK_WIDTH + 2 * ML_WIDTH + 4 * ML_HEADS
GLA_HEADS = 4
GLA_DK = 256
GLA_DV = 512
GLA_KW = GLA_HEADS * GLA_DK
GLA_VW = GLA_HEADS * GLA_DV
GLA_RANK = 16
GLA_TAU = 16.0
GLA_CHUNK = 64
ODD_SIZES = (GLA_KW, GLA_KW, GLA_VW, GLA_VW, GLA_RANK, GLA_RANK)
ODD_IN = 2 * GLA_KW + 2 * GLA_VW + 2 * GLA_RANK
D_FF = 5632
CONV_W = 3
N_EVEN = (DEPTH + 1) // 2
N_ODD = DEPTH // 2

kernel_name = 'hybrid_natten_mlstm_gla_encoder'


def _rms(x, gain):
    xf = x.astype(jnp.float32)
    y = xf * lax.rsqrt(jnp.mean(xf * xf, axis=-1, keepdims=True) + EPS)
    return (y * gain.astype(jnp.float32)).astype(x.dtype)


def _head_rms(y, n_heads, gain):
    b, t, w = y.shape
    yh = y.reshape(b, t, n_heads, w // n_heads)
    return _rms(yh, gain.reshape(n_heads, w // n_heads)).reshape(b, t, w)


def _split(a, sizes):
    return jnp.split(a, np.cumsum(sizes)[:-1].tolist(), axis=-1)


def _na_columns():
    j = np.arange(GRID_W // NA_QB)
    starts = np.clip(j * NA_QB - WIN_W // 2, 0, GRID_W - NA_KSPAN)
    col_idx = starts[:, None] + np.arange(NA_KSPAN)
    q_col = j[:, None] * NA_QB + np.arange(NA_QB)
    c0 = np.clip(q_col - WIN_W // 2, 0, GRID_W - WIN_W)[..., None]
    kc = col_idx[:, None, :]
    mask = (kc >= c0) & (kc < c0 + WIN_W)
    dc_idx = np.clip(kc - q_col[..., None] + WIN_W - 1, 0, 2 * WIN_W - 2)
    return col_idx, mask, dc_idx


def _neighbourhood_attention(q, k, v, rel_bias):
    b, t, h, d = q.shape
    n_real = t - N_META
    rows = n_real // GRID_W
    win_h = min(WIN_H, rows)
    n_cb = GRID_W // NA_QB
    scale = d ** -0.5
    qm, km, vm = q[:, :N_META], k[:, :N_META], v[:, :N_META]
    qg = q[:, N_META:].reshape(b, rows, GRID_W, h, d)
    kg = k[:, N_META:].reshape(b, rows, GRID_W, h, d)
    vg = v[:, N_META:].reshape(b, rows, GRID_W, h, d)
    s_mm = jnp.einsum('bqhd,bkhd->bhqk', qm, km) * scale
    y_meta = jnp.einsum('bhqk,bkhd->bqhd', jax.nn.softmax(s_mm, axis=-1), vm)
    col_idx, col_mask, dc_idx = _na_columns()
    n_loc = win_h * NA_KSPAN

    def one_row(r):
        r0 = jnp.clip(r - WIN_H // 2, 0, rows - win_h)
        kr = lax.dynamic_slice_in_dim(kg, r0, win_h, axis=1)
        vr = lax.dynamic_slice_in_dim(vg, r0, win_h, axis=1)
        kb = kr[:, :, col_idx]
        vb = vr[:, :, col_idx]
        qb = lax.dynamic_index_in_dim(qg, r, axis=1, keepdims=False).reshape(b, n_cb, NA_QB, h, d)
        s_loc = jnp.einsum('bjqhd,brjkhd->bhjqrk', qb, kb) * scale
        dr_idx = r0 - r + jnp.arange(win_h) + WIN_H - 1
        bias = jnp.transpose(rel_bias[:, dr_idx][:, :, dc_idx], (0, 2, 3, 1, 4))
        s_loc = jnp.where(col_mask[:, :, None, :], s_loc + bias, -jnp.inf).reshape(b, h, n_cb, NA_QB, n_loc)
        s_met = jnp.einsum('bjqhd,bmhd->bhjqm', qb, km) * scale
        p = jax.nn.softmax(jnp.concatenate([s_loc, s_met], axis=-1), axis=-1)
        p_loc = p[..., :n_loc].reshape(b, h, n_cb, NA_QB, win_h, NA_KSPAN)
        y = (jnp.einsum('bhjqrk,brjkhd->bjqhd', p_loc, vb)
             + jnp.einsum('bhjqm,bmhd->bjqhd', p[..., n_loc:], vm))
        return y.reshape(b, GRID_W, h, d)

    y_real = lax.map(one_row, jnp.arange(rows))
    y_real = jnp.moveaxis(y_real, 0, 1).reshape(b, n_real, h, d)
    return jnp.concatenate([y_meta, y_real], axis=1)


def _scan_chunks(step, state, xs, chunk):
    def split(a):
        bb, hh, tt = a.shape[:3]
        return jnp.moveaxis(a.reshape(bb, hh, tt // chunk, chunk, *a.shape[3:]), 2, 0)
    state, ys = lax.scan(step, state, tuple(split(a) for a in xs))
    n, bb, hh, c, e = ys.shape
    return state, jnp.moveaxis(ys, 0, 2).reshape(bb, hh, n * c, e)


def _bidirectional(step, init, xs_fwd, xs_bwd, chunk):
    meta = lambda xs: tuple(a[:, :, :N_META] for a in xs)
    real = lambda xs: tuple(a[:, :, N_META:] for a in xs)
    flip = lambda xs: tuple(jnp.flip(a, axis=2) for a in xs)
    s, y_meta_f = _scan_chunks(step, init, meta(xs_fwd), N_META)
    _, y_real_f = _scan_chunks(step, s, real(xs_fwd), chunk)
    s, y_real_b = _scan_chunks(step, init, flip(real(xs_bwd)), chunk)
    _, y_meta_b = _scan_chunks(step, s, flip(meta(xs_bwd)), N_META)
    y_f = jnp.concatenate([y_meta_f, y_real_f], axis=2)
    y_b = jnp.flip(jnp.concatenate([y_real_b, y_meta_b], axis=2), axis=2)
    return y_f + y_b


def _mlstm_chunk(state, inp):
    c_mat, n_vec, m = state
    q, k, v, ig, log_f = inp
    c = q.shape[2]
    tri = jnp.tril(jnp.ones((c, c), dtype=bool))
    bcum = jnp.cumsum(log_f, axis=-1)
    d_log = jnp.where(tri, bcum[..., :, None] - bcum[..., None, :] + ig[..., None, :], -jnp.inf)
    m_prev = bcum + m[..., None]
    m_t = jnp.maximum(m_prev, jnp.max(d_log, axis=-1))
    w_prev = jnp.exp(m_prev - m_t)
    p = jnp.exp(d_log - m_t[..., None]) * jnp.einsum('bhtd,bhsd->bhts', q, k)
    num = w_prev[..., None] * jnp.einsum('bhtd,bhde->bhte', q, c_mat) + jnp.einsum('bhts,bhse->bhte', p, v)
    den = w_prev * jnp.einsum('bhtd,bhd->bht', q, n_vec) + jnp.sum(p, axis=-1)
    h = num / jnp.maximum(jnp.abs(den), jnp.exp(-m_t))[..., None]
    g = bcum[..., -1:] - bcum + ig
    m_new = jnp.maximum(bcum[..., -1] + m, jnp.max(g, axis=-1))
    w_state = jnp.exp(bcum[..., -1] + m - m_new)
    w_tok = jnp.exp(g - m_new[..., None])
    c_new = w_state[..., None, None] * c_mat + jnp.einsum('bhs,bhsd,bhse->bhde', w_tok, k, v)
    n_new = w_state[..., None] * n_vec + jnp.einsum('bhs,bhsd->bhd', w_tok, k)
    return (c_new, n_new, m_new), h


def _gla_chunk(s_mat, inp):
    q, k, v, log_a = inp
    c = q.shape[2]
    tri = jnp.tril(jnp.ones((c, c), dtype=bool))
    bcum = jnp.cumsum(log_a, axis=2)
    decay = jnp.exp(jnp.where(tri[:, :, None], bcum[:, :, :, None, :] - bcum[:, :, None, :, :], -jnp.inf))
    a = jnp.einsum('bhtd,bhsd,bhtsd->bhts', q, k, decay)
    o = jnp.einsum('bhtd,bhde->bhte', q * jnp.exp(bcum), s_mat) + jnp.einsum('bhts,bhse->bhte', a, v)
    b_end = bcum[:, :, -1]
    s_new = (jnp.exp(b_end)[..., None] * s_mat
             + jnp.einsum('bhsd,bhse->bhde', k * jnp.exp(b_end[:, :, None] - bcum), v))
    return s_new, o


def _even_mixer(h, w_in, gate_bias, q_gain, k_gain, rel_bias, ml_gain, w_out):
    b, t, _ = h.shape
    f32 = jnp.float32
    q_na, k_na, v_na, q_ml, k_ml, v_ml, o_ml, g_ml = _split(h @ w_in, EVEN_SIZES)
    split_heads = lambda a, n: a.reshape(b, t, n, -1).astype(f32)
    y_na = _neighbourhood_attention(_rms(split_heads(q_na, NA_HEADS), q_gain),
                                    _rms(split_heads(k_na, NA_HEADS), k_gain),
                                    split_heads(v_na, NA_HEADS),
                                    rel_bias.astype(f32)).reshape(b, t, NA_WIDTH)
    to_bhtd = lambda a: split_heads(a, ML_HEADS).transpose(0, 2, 1, 3)
    gates = (g_ml.astype(f32) + gate_bias.astype(f32)).reshape(b, t, 4, ML_HEADS).transpose(2, 0, 3, 1)
    ig_f, fg_f, ig_b, fg_b = gates[0], gates[1], gates[2], gates[3]
    qh, kh, vh = to_bhtd(q_ml), to_bhtd(k_ml) * ML_QK ** -0.5, to_bhtd(v_ml)
    init = (jnp.zeros((b, ML_HEADS, ML_QK, ML_V), f32), jnp.zeros((b, ML_HEADS, ML_QK), f32),
            jnp.zeros((b, ML_HEADS), f32))
    h_ml = _bidirectional(_mlstm_chunk, init,
                          (qh, kh, vh, ig_f, jax.nn.log_sigmoid(fg_f)),
                          (qh, kh, vh, ig_b, jax.nn.log_sigmoid(fg_b)), ML_CHUNK)
    h_ml = h_ml.transpose(0, 2, 1, 3).reshape(b, t, ML_WIDTH)
    y_ml = _head_rms(h_ml, ML_HEADS, ml_gain) * jax.nn.sigmoid(o_ml.astype(f32))
    return jnp.concatenate([y_na, y_ml], axis=-1).astype(h.dtype) @ w_out


def _odd_mixer(h, w_in, gate_up, gate_bias, head_gain, w_out):
    b, t, _ = h.shape
    f32 = jnp.float32
    q, k, v, r, lr_f, lr_b = _split(h @ w_in, ODD_SIZES)
    to_bhtd = lambda a: a.reshape(b, t, GLA_HEADS, -1).astype(f32).transpose(0, 2, 1, 3)
    log_gate = lambda lr, j: jax.nn.log_sigmoid(lr.astype(f32) @ gate_up[j].astype(f32)
                                                + gate_bias[j].astype(f32)) / GLA_TAU
    qh, kh, vh = to_bhtd(q) * GLA_DK ** -0.5, to_bhtd(k), to_bhtd(v)
    init = jnp.zeros((b, GLA_HEADS, GLA_DK, GLA_DV), f32)
    o = _bidirectional(_gla_chunk, init,
                       (qh, kh, vh, to_bhtd(log_gate(lr_f, 0))),
                       (qh, kh, vh, to_bhtd(log_gate(lr_b, 1))), GLA_CHUNK)
    o = o.transpose(0, 2, 1, 3).reshape(b, t, GLA_VW)
    y = _head_rms(o, GLA_HEADS, head_gain) * jax.nn.silu(r.astype(f32))
    return y.astype(h.dtype) @ w_out


def _conv_ffn(h, w_up, conv_w, conv_b, w_down):
    u = h @ w_up
    t = u.shape[1]
    pad = CONV_W // 2
    up = jnp.pad(u, ((0, 0), (pad, CONV_W - 1 - pad), (0, 0)))
    acc = conv_b
    for i in range(CONV_W):
        acc = acc + up[:, i:i + t] * conv_w[i]
    g, val = jnp.split(acc, 2, axis=-1)
    return (jax.nn.silu(g) * val) @ w_down


def setup_inputs(seed: int = 0) -> dict:
    key = jax.random.key(seed)
    ks = jax.random.split(key, 24)
    nrm = lambda kk, shape, scale: jax.random.normal(kk, shape, jnp.float32) * scale
    gain = lambda kk, shape: 1.0 + nrm(kk, shape, 0.02)
    f_bias = jnp.linspace(3.0, 6.0, ML_HEADS, dtype=jnp.float32)
    zeros_h = jnp.zeros((ML_HEADS,), jnp.float32)
    gate_offset = jnp.concatenate([zeros_h, f_bias, zeros_h, f_bias])
    return {
        'x': nrm(ks[0], (BATCH, SEQ, D_MODEL), 1.0),
        'meta_tokens': nrm(ks[1], (N_META, D_MODEL), 1.0),
        'norm_mix': gain(ks[2], (DEPTH, D_MODEL)),
        'norm_ffn': gain(ks[3], (DEPTH, D_MODEL)),
        'ab_w_in': nrm(ks[4], (N_EVEN, D_MODEL, EVEN_IN), D_MODEL ** -0.5),
        'ab_gate_bias': nrm(ks[5], (N_EVEN, 4 * ML_HEADS), 0.01) + gate_offset,
        'ab_q_gain': gain(ks[6], (N_EVEN, NA_DIM)),
        'ab_k_gain': gain(ks[7], (N_EVEN, NA_DIM)),
        'ab_rel_bias': nrm(ks[8], (N_EVEN, NA_HEADS, 2 * WIN_H - 1, 2 * WIN_W - 1), 0.02),
        'ab_ml_gain': gain(ks[9], (N_EVEN, ML_WIDTH)),
        'ab_w_out': nrm(ks[10], (N_EVEN, MIX_WIDTH, D_MODEL), MIX_WIDTH ** -0.5),
        'c_w_in': nrm(ks[11], (N_ODD, D_MODEL, ODD_IN), D_MODEL ** -0.5),
        'c_gate_up': nrm(ks[12], (N_ODD, 2, GLA_RANK, GLA_KW), GLA_RANK ** -0.5),
        'c_gate_bias': nrm(ks[13], (N_ODD, 2, GLA_KW), 0.1),
        'c_head_gain': gain(ks[14], (N_ODD, GLA_VW)),
        'c_w_out': nrm(ks[15], (N_ODD, GLA_VW, D_MODEL), GLA_VW ** -0.5),
        'ffn_w_up': nrm(ks[16], (DEPTH, D_MODEL, 2 * D_FF), D_MODEL ** -0.5),
        'ffn_conv_w': nrm(ks[17], (DEPTH, CONV_W, 2 * D_FF), CONV_W ** -0.5),
        'ffn_conv_b': nrm(ks[18], (DEPTH, 2 * D_FF), 0.01),
        'ffn_w_down': nrm(ks[19], (DEPTH, D_FF, D_MODEL), D_FF ** -0.5),
    }


def reference(x, meta_tokens, norm_mix, norm_ffn, ab_w_in, ab_gate_bias, ab_q_gain, ab_k_gain,
              ab_rel_bias, ab_ml_gain, ab_w_out, c_w_in, c_gate_up, c_gate_bias, c_head_gain,
              c_w_out, ffn_w_up, ffn_conv_w, ffn_conv_b, ffn_w_down):
    b = x.shape[0]
    meta = jnp.broadcast_to(meta_tokens.astype(x.dtype)[None], (b, N_META, x.shape[-1]))
    h = jnp.concatenate([meta, x], axis=1)
    for i in range(DEPTH):
        j = i // 2
        hn = _rms(h, norm_mix[i])
        if i % 2 == 0:
            h = h + _even_mixer(hn, ab_w_in[j], ab_gate_bias[j], ab_q_gain[j], ab_k_gain[j],
                                ab_rel_bias[j], ab_ml_gain[j], ab_w_out[j])
        else:
            h = h + _odd_mixer(hn, c_w_in[j], c_gate_up[j], c_gate_bias[j], c_head_gain[j], c_w_out[j])
        h = h + _conv_ffn(_rms(h, norm_ffn[i]), ffn_w_up[i], ffn_conv_w[i], ffn_conv_b[i], ffn_w_down[i])
    return h[:, N_META:]
```

```cpp
#include <hip/hip_runtime.h>
#include <hip/hip_cooperative_groups.h>
#include <cstdio>
#include <cstdint>
namespace cg = cooperative_groups;

#define LAS __attribute__((address_space(3)))
typedef unsigned short bf16_t;
typedef short bf16x8 __attribute__((ext_vector_type(8)));
typedef float f32x4 __attribute__((ext_vector_type(4)));
typedef unsigned u32x4 __attribute__((ext_vector_type(4)));
typedef unsigned u32x2 __attribute__((ext_vector_type(2)));

constexpr int NB = 2, T = 16400, SEQ = 16384, DM = 2048, M = NB * T, MPAD = 33024, NMT = 129;
constexpr int NAT0 = 5376, NAT1 = 6400, FF = 5632, FF2 = 11264;
constexpr int C_QNA = 0, C_KNA = 1024, C_QML = 2048, C_KML = 2560, C_VML = 3072, C_OML = 4096, C_GML = 5120;
constexpr int C_GQ = 0, C_GK = 1024, C_GV = 2048, C_GR = 4096, C_GLR = 6144;
constexpr float EPS = 1e-6f;
constexpr float LOG2E = 1.4426950408889634f;

constexpr size_t MiB = 1u << 20;
constexpr size_t OFF_CTL = 0, CTL_BYTES = 1 * MiB;
constexpr size_t OFF_SSQ = 64 * 1024;
constexpr size_t OFF_HMETA = 1 * MiB;
constexpr size_t OFF_ELAST = 2 * MiB;
constexpr size_t OFF_W1 = 8 * MiB;
constexpr size_t W_NAT1 = 0, W_OUT1 = (size_t)NAT1 * 4096, W_UP1 = W_OUT1 + 8 * MiB, W_DN1 = W_UP1 + 44 * MiB, W1_BYTES = W_DN1 + 22 * MiB;
constexpr size_t OFF_HB = 112 * MiB;
constexpr size_t OFF_NAT = 242 * MiB;
constexpr size_t OFF_MIX = 646 * MiB;
constexpr size_t OFF_W0 = 775 * MiB;
constexpr size_t W_NAT0 = 0, W_TR0 = 21 * MiB, W_OUT0 = 25 * MiB, W_UP0 = 33 * MiB, W_DN0 = 77 * MiB;
constexpr size_t OFF_TR = 874 * MiB;
constexpr size_t WS_NEED = 1000 * MiB;
static_assert(OFF_W1 + W1_BYTES <= OFF_HB, "map");
static_assert(OFF_HB + (size_t)(MPAD + 256) * 4096 <= OFF_NAT, "map");
static_assert(OFF_NAT + (size_t)MPAD * NAT1 * 2 <= OFF_MIX, "map");
static_assert(OFF_MIX + (size_t)MPAD * 4096 <= OFF_W0, "map");
static_assert(OFF_W0 + 99 * MiB <= OFF_TR && OFF_TR + (size_t)1024 * MPAD * 2 <= WS_NEED, "map");
static_assert(OFF_W0 + (size_t)MPAD * 4096 <= WS_NEED, "map");
static_assert((size_t)NAT0 * 4096 <= 21 * MiB, "map");

constexpr int LDS_BYTES = 147456;
constexpr int LDS_XCH = 131072;

struct Params { const float* in[20]; float* out; unsigned char* ws; };

__device__ __forceinline__ unsigned f2bf(float f) { unsigned u = __builtin_bit_cast(unsigned, f); return (u + 0x7fffu + ((u >> 16) & 1u)) >> 16; }
typedef float f32x2_pk __attribute__((ext_vector_type(2))); typedef __bf16 bf16x2_pk __attribute__((ext_vector_type(2)));
__device__ __forceinline__ unsigned pk2(float lo, float hi) { f32x2_pk v = {lo, hi}; bf16x2_pk b = __builtin_convertvector(v, bf16x2_pk); return __builtin_bit_cast(unsigned, b); }
__device__ __forceinline__ float bflo(unsigned u) { return __builtin_bit_cast(float, u << 16); }
__device__ __forceinline__ float bfhi(unsigned u) { return __builtin_bit_cast(float, u & 0xffff0000u); }
__device__ __forceinline__ float bf1(bf16_t v) { return __builtin_bit_cast(float, ((unsigned)v) << 16); }
__device__ __forceinline__ int lane_id_v() { int l; asm volatile("v_mbcnt_lo_u32_b32 %0, -1, 0\n\tv_mbcnt_hi_u32_b32 %0, -1, %0" : "=v"(l)); return l; }
__device__ __forceinline__ float sxor(float v, int m) { const int l = lane_id_v(); return __builtin_bit_cast(float, __builtin_amdgcn_ds_bpermute((l ^ m) << 2, __builtin_bit_cast(int, v))); }
__device__ __forceinline__ float sup(float v, int o) { const int l = lane_id_v(); return __builtin_bit_cast(float, __builtin_amdgcn_ds_bpermute(((l - o) & 63) << 2, __builtin_bit_cast(int, v))); }
__device__ __forceinline__ float sdown(float v, int o) { const int l = lane_id_v(); return __builtin_bit_cast(float, __builtin_amdgcn_ds_bpermute(((l + o) & 63) << 2, __builtin_bit_cast(int, v))); }
__device__ __forceinline__ float wave_sum(float v) {
#pragma unroll
    for (int o = 1; o < 64; o <<= 1) v += sxor(v, o);
    return v;
}
#define LDS_WAIT() asm volatile("s_waitcnt lgkmcnt(0)" ::: "memory")
#define BAR_LDS() do { asm volatile("s_waitcnt lgkmcnt(0)" ::: "memory"); __builtin_amdgcn_s_barrier(); asm volatile("" ::: "memory"); } while (0)
__device__ __forceinline__ int lane_id_v();
__device__ __forceinline__ int phase_tid(int wv) { return wv * 64 + lane_id_v(); }
__device__ __forceinline__ f32x4 mfma16(bf16x8 a, bf16x8 b, f32x4 c) { return __builtin_amdgcn_mfma_f32_16x16x32_bf16(a, b, c, 0, 0, 0); }
__device__ __forceinline__ float log_sigmoid(float x) { return fminf(x, 0.f) - __logf(1.0f + __expf(-fabsf(x))); }

namespace pg8 {
constexpr int BM = 256, BK = 64, HALF = 128, HTB = HALF * BK * 2, STAGE_BYTES = 8 * HTB, NXCD = 8, WGM = 4;
__host__ __device__ __forceinline__ int lds_byte(int r, int c) { const int st = (r >> 4) * 2 + (c >> 5), rr = r & 15, cc = c & 31, ob = rr * 64 + cc * 2; return st * 1024 + (ob ^ (((ob >> 9) & 1) << 5)); }
__host__ __device__ __forceinline__ void stage_rc(int b, int& R, int& C) { const int st = b / 1024, sb = b % 1024, swz = sb ^ (((sb >> 9) & 1) << 5); R = (st >> 1) * 16 + swz / 64; C = (st & 1) * 32 + (swz % 64) / 2; }
__host__ __device__ __forceinline__ int perm32(int rho) { const int n = rho >> 4, i = rho & 15; return 8 * (i >> 2) + 4 * n + (i & 3); }

struct Unit { int pm, pn; };
struct Gemm { const bf16_t* A; const bf16_t* Bt; int K; };

struct Order {
    int nM, nN, nwg, G, c, mode;
    __device__ void init(int nM_, int nN_, int G_, int c_, int mode_) { nM = nM_; nN = nN_; nwg = nM * nN; G = G_; c = c_; mode = mode_; }
    __device__ bool next(int i, Unit& u) const {
        const long L = (long)i * G + c; if (L >= nwg) return false;
        int wgid = (int)L; { const int q = nwg / NXCD, r = nwg % NXCD, xcd = wgid % NXCD, off = wgid / NXCD; wgid = (xcd < r ? xcd * (q + 1) : r * (q + 1) + (xcd - r) * q) + off; }
        const int nig = WGM * nN, gid = wgid / nig, fm = gid * WGM, gsz = (nM - fm) < WGM ? (nM - fm) : WGM;
        u.pm = fm + ((wgid % nig) % gsz); u.pn = (wgid % nig) / gsz; return true;
    }
    __device__ __forceinline__ long arow(const Unit& u) const { return mode ? (long)(u.pm / 65) * T + (long)(u.pm % 65) * 254 - 1 : (long)u.pm * 256; }
};

typedef float f32x2_t __attribute__((ext_vector_type(2))); typedef __bf16 bf16x2_t __attribute__((ext_vector_type(2)));
__device__ __forceinline__ unsigned cvt_pk_bf16(float lo, float hi) { f32x2_t v = {lo, hi}; bf16x2_t b = __builtin_convertvector(v, bf16x2_t); return __builtin_bit_cast(unsigned, b); }

struct EpiScale {
    static constexpr bool PERM = true;
    bf16_t* O; int ldc; const float* ssq;
    __device__ __forceinline__ void operator()(f32x4 (&acc)[2][2][4][2], const Unit& u, int wr, int wc, int fr, int fq) const {
#pragma unroll
        for (int ai = 0; ai < 2; ++ai)
#pragma unroll
            for (int m = 0; m < 4; ++m) {
                const int g = u.pm * BM + ai * HALF + wr * 64 + m * 16 + fr; const bool ok = g < M;
                const float rs = ok ? rsqrtf(ssq[g] * (1.0f / DM) + EPS) : 0.f;
                bf16_t* rowp = O + (size_t)g * ldc + u.pn * BM + wc * 32 + 8 * fq;
#pragma unroll
                for (int bj = 0; bj < 2; ++bj) {
                    f32x4 v0 = acc[ai][bj][m][0], v1 = acc[ai][bj][m][1]; u32x4 w;
                    if (ok) { w.x = cvt_pk_bf16(v0[0] * rs, v0[1] * rs); w.y = cvt_pk_bf16(v0[2] * rs, v0[3] * rs); w.z = cvt_pk_bf16(v1[0] * rs, v1[1] * rs); w.w = cvt_pk_bf16(v1[2] * rs, v1[3] * rs); }
                    else { w = (u32x4){0u, 0u, 0u, 0u}; }
                    *(u32x4*)(rowp + bj * HALF) = w;
                }
            }
    }
};
struct EpiScaleT {
    static constexpr bool PERM = true;
    bf16_t* O; const float* ssq;
    __device__ __forceinline__ void operator()(f32x4 (&acc)[2][2][4][2], const Unit& u, int wr, int wc, int fr, int fq) const {
        f32x4 rs[2][2];
#pragma unroll
        for (int bj = 0; bj < 2; ++bj)
#pragma unroll
            for (int n = 0; n < 2; ++n) { const int tk = u.pn * BM + bj * HALF + wc * 32 + 8 * fq + 4 * n;
#pragma unroll
                for (int e = 0; e < 4; ++e) rs[bj][n][e] = (tk + e) < M ? rsqrtf(ssq[tk + e] * (1.0f / DM) + EPS) : 0.f; }
#pragma unroll
        for (int ai = 0; ai < 2; ++ai)
#pragma unroll
            for (int m = 0; m < 4; ++m) {
                const int g = u.pm * BM + ai * HALF + wr * 64 + m * 16 + fr;
                bf16_t* rowp = O + (size_t)g * MPAD + u.pn * BM + wc * 32 + 8 * fq;
#pragma unroll
                for (int bj = 0; bj < 2; ++bj) {
                    f32x4 v0 = acc[ai][bj][m][0], v1 = acc[ai][bj][m][1]; u32x4 w;
#pragma unroll
                    for (int e = 0; e < 4; ++e) { v0[e] = rs[bj][0][e] != 0.f ? v0[e] * rs[bj][0][e] : 0.f; v1[e] = rs[bj][1][e] != 0.f ? v1[e] * rs[bj][1][e] : 0.f; }
                    w.x = cvt_pk_bf16(v0[0], v0[1]); w.y = cvt_pk_bf16(v0[2], v0[3]); w.z = cvt_pk_bf16(v1[0], v1[1]); w.w = cvt_pk_bf16(v1[2], v1[3]);
                    *(u32x4*)(rowp + bj * HALF) = w;
                }
            }
    }
};
struct EpiRes {
    static constexpr bool PERM = true;
    const float* srcx; const float* srcm; float* dstx; float* dstm; bf16_t* hb; float* ssq;
    __device__ __forceinline__ void operator()(f32x4 (&acc)[2][2][4][2], const Unit& u, int wr, int wc, int fr, int fq) const {
#pragma unroll
        for (int ai = 0; ai < 2; ++ai)
#pragma unroll
            for (int m = 0; m < 4; ++m) {
                const int g = u.pm * BM + ai * HALF + wr * 64 + m * 16 + fr; float ss = 0.f;
                if (g < M) {
                    const int b = g >= T ? 1 : 0, t = g - b * T;
                    const float* sp = t < 16 ? srcm + (size_t)(b * 16 + t) * DM : srcx + ((size_t)b * SEQ + (t - 16)) * DM;
                    float* dp = t < 16 ? (dstm ? dstm + (size_t)(b * 16 + t) * DM : (float*)nullptr) : dstx + ((size_t)b * SEQ + (t - 16)) * DM;
                    const int col0 = u.pn * BM + wc * 32 + 8 * fq;
#pragma unroll
                    for (int bj = 0; bj < 2; ++bj) {
                        const int col = col0 + bj * HALF;
                        const f32x4 v0 = *(const f32x4*)(sp + col) + acc[ai][bj][m][0], v1 = *(const f32x4*)(sp + col + 4) + acc[ai][bj][m][1];
                        if (dp) { *(f32x4*)(dp + col) = v0; *(f32x4*)(dp + col + 4) = v1; }
                        if (hb) { u32x4 w; w.x = cvt_pk_bf16(v0[0], v0[1]); w.y = cvt_pk_bf16(v0[2], v0[3]); w.z = cvt_pk_bf16(v1[0], v1[1]); w.w = cvt_pk_bf16(v1[2], v1[3]); *(u32x4*)(hb + (size_t)g * DM + col) = w; }
                        ss += (v0[0] * v0[0] + v0[1] * v0[1]) + (v0[2] * v0[2] + v0[3] * v0[3]) + (v1[0] * v1[0] + v1[1] * v1[1]) + (v1[2] * v1[2] + v1[3] * v1[3]);
                    }
                }
                ss += sxor(ss, 16); ss += sxor(ss, 32);
                if (ssq && fq == 0 && g < M) atomicAdd(ssq + g, ss);
            }
    }
};
__device__ __forceinline__ float dppf(float old, float src, const int ctrl_sel) {
    int r;
    if (ctrl_sel == 0) r = __builtin_amdgcn_mov_dpp(__builtin_bit_cast(int, src), 0x121, 0xf, 0xf, true);
    else if (ctrl_sel == 1) r = __builtin_amdgcn_update_dpp(__builtin_bit_cast(int, old), __builtin_bit_cast(int, src), 0x111, 0xf, 0xf, false);
    else if (ctrl_sel == 2) r = __builtin_amdgcn_mov_dpp(__builtin_bit_cast(int, src), 0x12f, 0xf, 0xf, true);
    else r = __builtin_amdgcn_update_dpp(__builtin_bit_cast(int, old), __builtin_bit_cast(int, src), 0x101, 0xf, 0xf, false);
    return __builtin_bit_cast(float, r);
}
struct EpiFfn {
    static constexpr bool PERM = true;
    bf16_t* act; const float* ssq; const float* cw; const float* cb; LAS float* xl;
    __device__ __forceinline__ void operator()(f32x4 (&acc)[2][2][4][2], const Unit& u, int wr, int wc, int fr_in, int fq_in) const {
        int lane_e; asm volatile("v_mbcnt_lo_u32_b32 %0, -1, 0\n\tv_mbcnt_hi_u32_b32 %0, -1, %0" : "=v"(lane_e));
        int fr = lane_e & 15, fq = lane_e >> 4; (void)fr_in; (void)fq_in;
        const int b = u.pm / 65, jt = u.pm % 65, tb = jt * 254 - 1;
#pragma unroll
        for (int ai = 0; ai < 2; ++ai)
#pragma unroll
            for (int m = 0; m < 4; ++m) {
                const int t = tb + ai * HALF + wr * 64 + m * 16 + fr; const bool ok = (t >= 0) && (t < T);
                const float rs = ok ? rsqrtf(ssq[b * T + (ok ? t : 0)] * (1.0f / DM) + EPS) : 0.f;
#pragma unroll
                for (int bj = 0; bj < 2; ++bj)
#pragma unroll
                    for (int n = 0; n < 2; ++n)
#pragma unroll
                        for (int e = 0; e < 4; ++e) acc[ai][bj][m][n][e] = acc[ai][bj][m][n][e] * rs;
            }
        asm volatile("" : "+v"(fr), "+v"(fq));
#pragma unroll
        for (int ai = 0; ai < 2; ++ai) { const int blk = 2 * ai + wr;
#pragma unroll
            for (int bj = 0; bj < 2; ++bj)
#pragma unroll
                for (int n = 0; n < 2; ++n) {
                    if (fr == 0)  *(LAS f32x4*)(xl + ((((blk * 2 + 0) * 4 + wc) * 2 + bj) * 32 + 8 * fq + 4 * n)) = acc[ai][bj][0][n];
                    if (fr == 15) *(LAS f32x4*)(xl + ((((blk * 2 + 1) * 4 + wc) * 2 + bj) * 32 + 8 * fq + 4 * n)) = acc[ai][bj][3][n];
                } }
        LAS float* pl = xl + 2048;
        { const int tix = (wr * 4 + wc) * 64 + (fq * 16 + fr);
#pragma unroll
          for (int i = 0; i < 2; ++i) { const int id = tix + 512 * i, k = id >> 8, tc = id & 255; const int ch = (tc < 128 ? 0 : FF) + u.pn * HALF + (tc & 127);
              pl[id] = k < 3 ? cw[k * FF2 + ch] : cb[ch]; } }
        LDS_WAIT(); __builtin_amdgcn_s_barrier(); asm volatile("" ::: "memory");
        asm volatile("" : "+v"(fr), "+v"(fq));
        LAS float* pb = pl + wc * 32 + 8 * fq; asm volatile("" : "+v"(pb));
        LAS float* xb = xl + 512 + wr * 512 + wc * 64 + 8 * fq - 512 - 512; asm volatile("" : "+v"(xb));
#pragma unroll
        for (int ai = 0; ai < 2; ++ai) { const int blk = 2 * ai + wr;
#pragma unroll
            for (int m = 0; m < 4; ++m) {
                const int r = ai * HALF + wr * 64 + m * 16 + fr, t = tb + r;
                float o[8];
#pragma unroll
                for (int n = 0; n < 2; ++n) {
                    f32x4 y[2];
#pragma unroll
                    for (int bj = 0; bj < 2; ++bj) {
                        const int pc = bj * 128 + 4 * n;
                        const f32x4 w0 = *(LAS const f32x4*)(pb + pc), w1 = *(LAS const f32x4*)(pb + 256 + pc), w2 = *(LAS const f32x4*)(pb + 512 + pc), bb = *(LAS const f32x4*)(pb + 768 + pc);
                        f32x4 ps, ns;
                        if (m > 0) ps = acc[ai][bj][m > 0 ? m - 1 : 0][n];
                        else ps = blk > 0 ? *(LAS const f32x4*)(xb + (ai * 1024 + 256 + bj * 32 + 4 * n)) : (f32x4){0.f, 0.f, 0.f, 0.f};
                        if (m < 3) ns = acc[ai][bj][m < 3 ? m + 1 : 3][n];
                        else ns = blk < 3 ? *(LAS const f32x4*)(xb + (ai * 1024 + 1024 + bj * 32 + 4 * n)) : (f32x4){0.f, 0.f, 0.f, 0.f};
                        const f32x4 cur = acc[ai][bj][m][n];
#pragma unroll
                        for (int e = 0; e < 4; ++e) {
                            const float t1 = m > 0 ? dppf(0.f, ps[e], 0) : ps[e];
                            const float pv = dppf(t1, cur[e], 1);
                            const float t2 = m < 3 ? dppf(0.f, ns[e], 2) : ns[e];
                            const float nx = dppf(t2, cur[e], 3);
                            y[bj][e] = bb[e] + w0[e] * pv + w1[e] * cur[e] + w2[e] * nx;
                        }
                        __builtin_amdgcn_sched_barrier(0);
                    }
#pragma unroll
                    for (int e = 0; e < 4; ++e) { const float g = y[0][e]; o[4 * n + e] = g * y[1][e] * __builtin_amdgcn_rcpf(1.0f + __expf(-g)); }
                }
                if (r >= 1 && r < 255 && t < T) {
                    u32x4 w; w.x = cvt_pk_bf16(o[0], o[1]); w.y = cvt_pk_bf16(o[2], o[3]); w.z = cvt_pk_bf16(o[4], o[5]); w.w = cvt_pk_bf16(o[6], o[7]);
                    *(u32x4*)(act + (size_t)(b * T + t) * FF + u.pn * HALF + wc * 32 + 8 * fq) = w;
                }
                __builtin_amdgcn_sched_barrier(0);
            }
        }
    }
};

template <class Epi>
__device__ __forceinline__ void gemm_phase(LAS unsigned char* lds, const Gemm g, const Order& S, const Epi& E, int wv) {
    const int tid = phase_tid(wv), wid = __builtin_amdgcn_readfirstlane(tid >> 6), lane = tid & 63, wr = wid >> 2, wc = wid & 3, fr = lane & 15, fq = lane >> 4;
    const int K = g.K, nt = K / BK;
    unsigned voffA[2], voffB[2];
#pragma unroll
    for (int i = 0; i < 2; ++i) { int R, C; stage_rc(tid * 16 + i * 8192, R, C); const int Rb = Epi::PERM ? ((R & ~31) + perm32(R & 31)) : R;
        voffA[i] = (unsigned)(R * K + C) * 2u; voffB[i] = (unsigned)(Rb * K + C) * 2u; }
    const size_t kstep = (size_t)(BK * 2);
    const size_t hstep = (size_t)HALF * K * 2;
    const size_t tstep = 2 * hstep;
    const long rowb = (long)K * 2;
    const unsigned ldsw = (unsigned)wid * 1024u;
    const int aoff = lds_byte(wr * 64 + fr, fq * 8), boff = lds_byte(wc * 32 + fr, fq * 8);
#define PG8_SA(b, h) (((b) * 2 + (h)) * HTB)
#define PG8_SB(b, h) ((4 + (b) * 2 + (h)) * HTB)
#define PG8_STAGE(bufoff, gbase, voff) do { _Pragma("unroll") for (int _i = 0; _i < 2; ++_i) \
        __builtin_amdgcn_global_load_lds((const unsigned*)((const char*)(gbase) + (voff)[_i]), (LAS unsigned*)(lds + (bufoff) + ldsw + _i * 8192), 16, 0, 0); } while (0)
#define PG8_LDA(dst, b, h) do { _Pragma("unroll") for (int m = 0; m < 4; ++m) _Pragma("unroll") for (int k = 0; k < 2; ++k) dst[m][k] = *(const LAS bf16x8*)(lds + PG8_SA(b, h) + aoff + m * 2048 + k * 1024); } while (0)
#define PG8_LDB(dst, b, h) do { _Pragma("unroll") for (int n = 0; n < 2; ++n) _Pragma("unroll") for (int k = 0; k < 2; ++k) dst[n][k] = *(const LAS bf16x8*)(lds + PG8_SB(b, h) + boff + n * 2048 + k * 1024); } while (0)
#define PG8_MMA(ai, bj, At, Bt) do { __builtin_amdgcn_s_setprio(1); _Pragma("unroll") for (int m = 0; m < 4; ++m) _Pragma("unroll") for (int n = 0; n < 2; ++n) _Pragma("unroll") for (int k = 0; k < 2; ++k) \
        acc[ai][bj][m][n] = __builtin_amdgcn_mfma_f32_16x16x32_bf16(Bt[n][k], At[m][k], acc[ai][bj][m][n], 0, 0, 0); __builtin_amdgcn_s_setprio(0); } while (0)
#define PG8_WAIT_V(n) asm volatile("s_waitcnt vmcnt(" #n ")" ::: "memory")
#define PG8_WAIT_L(n) asm volatile("s_waitcnt lgkmcnt(" #n ")" ::: "memory")
#define PG8_BAR __builtin_amdgcn_s_barrier()
#define PG8_SCHED __builtin_amdgcn_sched_barrier(0)
    Unit cur, nxt; int ui = 0;
    if (!S.next(0, cur)) return;
    f32x4 acc[2][2][4][2];
#pragma unroll
    for (int a = 0; a < 2; ++a)
#pragma unroll
        for (int b = 0; b < 2; ++b)
#pragma unroll
            for (int m = 0; m < 4; ++m)
#pragma unroll
                for (int n = 0; n < 2; ++n) acc[a][b][m][n] = (f32x4){0.f, 0.f, 0.f, 0.f};
    bf16x8 At[4][2], B0[2][2], B1[2][2];
    const char* cA = (const char*)g.A + S.arow(cur) * rowb; const char* cB = (const char*)g.Bt + (size_t)cur.pn * tstep;
    PG8_STAGE(PG8_SB(0, 0), cB, voffB); PG8_STAGE(PG8_SB(0, 1), cB + hstep, voffB); PG8_STAGE(PG8_SA(0, 0), cA, voffA); PG8_STAGE(PG8_SA(0, 1), cA + hstep, voffA);
    if (wr == 1) PG8_BAR;
    PG8_WAIT_V(2); PG8_BAR;
    PG8_STAGE(PG8_SB(1, 0), cB + kstep, voffB); PG8_STAGE(PG8_SA(1, 0), cA + kstep, voffA); PG8_STAGE(PG8_SB(1, 1), cB + hstep + kstep, voffB);
    PG8_WAIT_V(6); PG8_BAR;
    for (;;) {
        const bool has_next = S.next(ui + 1, nxt);
        const char* nA = has_next ? (const char*)g.A + S.arow(nxt) * rowb : cA; const char* nB = has_next ? (const char*)g.Bt + (size_t)nxt.pn * tstep : cB;
        for (int t = 0; t < nt; t += 2) {
            const bool last = (t == nt - 2);
            const char* a1 = cA + (size_t)(t + 1) * kstep;
            const char* a2 = last ? nA : cA + (size_t)(t + 2) * kstep; const char* b2 = last ? nB : cB + (size_t)(t + 2) * kstep;
            const char* a3 = a2 + kstep; const char* b3 = b2 + kstep;
            PG8_LDB(B0, 0, 0); PG8_LDB(B1, 0, 1); PG8_SCHED; PG8_LDA(At, 0, 0); PG8_STAGE(PG8_SA(1, 1), a1 + hstep, voffA);
            PG8_WAIT_V(8); PG8_WAIT_L(0); PG8_BAR; PG8_MMA(0, 0, At, B0); PG8_MMA(0, 1, At, B1); PG8_BAR; PG8_SCHED;
            PG8_LDA(At, 0, 1); PG8_STAGE(PG8_SB(0, 0), b2, voffB); PG8_STAGE(PG8_SB(0, 1), b2 + hstep, voffB); PG8_STAGE(PG8_SA(0, 0), a2, voffA);
            PG8_WAIT_V(8); PG8_WAIT_L(0); PG8_BAR; PG8_MMA(1, 0, At, B0); PG8_MMA(1, 1, At, B1); PG8_BAR; PG8_SCHED;
            PG8_LDB(B0, 1, 0); PG8_LDB(B1, 1, 1); PG8_SCHED; PG8_LDA(At, 1, 0); PG8_STAGE(PG8_SA(0, 1), a2 + hstep, voffA);
            PG8_WAIT_V(8); PG8_WAIT_L(0); PG8_BAR; PG8_MMA(0, 0, At, B0); PG8_MMA(0, 1, At, B1); PG8_BAR; PG8_SCHED;
            PG8_LDA(At, 1, 1); PG8_STAGE(PG8_SB(1, 0), b3, voffB); PG8_STAGE(PG8_SB(1, 1), b3 + hstep, voffB); PG8_STAGE(PG8_SA(1, 0), a3, voffA);
            PG8_WAIT_V(8); PG8_WAIT_L(0); PG8_BAR; PG8_MMA(1, 0, At, B0); PG8_MMA(1, 1, At, B1); PG8_BAR; PG8_SCHED;
        }
        if (wr == 0) PG8_BAR;
        E(acc, cur, wr, wc, fr, fq);
        if (!has_next) break;
#pragma unroll
        for (int a = 0; a < 2; ++a)
#pragma unroll
            for (int b = 0; b < 2; ++b)
#pragma unroll
                for (int m = 0; m < 4; ++m)
#pragma unroll
                    for (int n = 0; n < 2; ++n) acc[a][b][m][n] = (f32x4){0.f, 0.f, 0.f, 0.f};
        cur = nxt; cA = nA; cB = nB; ++ui;
        if (wr == 1) PG8_BAR;
    }
    PG8_WAIT_V(0);
    PG8_BAR;
#undef PG8_SA
#undef PG8_SB
#undef PG8_STAGE
#undef PG8_LDA
#undef PG8_LDB
#undef PG8_MMA
#undef PG8_WAIT_V
#undef PG8_WAIT_L
#undef PG8_BAR
#undef PG8_SCHED
}
}

struct Job { const float* W; int K, ldw, c0, nc; bf16_t* dst; int ldd; const float* gain; float cs; int mode; };
__device__ __forceinline__ int ffnrow(int c) { return c < FF ? 256 * (c >> 7) + (c & 127) : 256 * ((c - FF) >> 7) + 128 + ((c - FF) & 127); }
__device__ __forceinline__ void conv_item(const Job& J, int item, LAS float* scr, int lane) {
    const int nblk = (J.nc + 63) >> 6, kb = item / nblk, nb = item % nblk, k0 = 64 * kb, n0 = 64 * nb;
    const int c4 = 4 * (lane & 15), kr = lane >> 4; const bool cv = (n0 + c4) < J.nc;
#pragma unroll
    for (int hb_ = 0; hb_ < 2; ++hb_) {
        f32x4 v[8];
#pragma unroll
        for (int i = 0; i < 8; ++i) { const int kk = 32 * hb_ + 4 * i + kr;
            v[i] = cv ? *(const f32x4*)(J.W + (size_t)(k0 + kk) * J.ldw + J.c0 + n0 + c4) : (f32x4){0.f, 0.f, 0.f, 0.f}; }
#pragma unroll
        for (int i = 0; i < 8; ++i) { const int kk = 32 * hb_ + 4 * i + kr; const float gm = (J.gain ? J.gain[k0 + kk] : 1.0f) * J.cs;
            LAS float* s = scr + kk * 65 + c4; s[0] = v[i][0] * gm; s[1] = v[i][1] * gm; s[2] = v[i][2] * gm; s[3] = v[i][3] * gm; }
    }
    LDS_WAIT(); asm volatile("" ::: "memory");
    const int c = lane & 7;
#pragma unroll
    for (int j = 0; j < 8; ++j) { const int n = (lane >> 3) + 8 * j; const LAS float* s = scr + (8 * c) * 65 + n;
        u32x4 o; o.x = pk2(s[0 * 65], s[1 * 65]); o.y = pk2(s[2 * 65], s[3 * 65]); o.z = pk2(s[4 * 65], s[5 * 65]); o.w = pk2(s[6 * 65], s[7 * 65]);
        if (n0 + n < J.nc) { const int drow = J.mode ? ffnrow(J.c0 + n0 + n) : (n0 + n);
            *(u32x4*)(J.dst + (size_t)drow * J.ldd + k0 + 8 * c) = o; } }
    LDS_WAIT(); asm volatile("" ::: "memory");
}
__device__ __forceinline__ Job get_job(const Params& p, int j) {
    unsigned char* ws = p.ws;
    bf16_t* natw0 = (bf16_t*)(ws + OFF_W0 + W_NAT0); bf16_t* trw0 = (bf16_t*)(ws + OFF_W0 + W_TR0);
    bf16_t* natw1 = (bf16_t*)(ws + OFF_W1 + W_NAT1);
    Job J; J.gain = nullptr; J.cs = 1.f; J.mode = 0; J.K = DM; J.ldd = DM;
    switch (j) {
    case 0: J.W = p.in[4]; J.ldw = 6160; J.c0 = 0; J.nc = 2048; J.dst = natw0; J.gain = p.in[2]; break;
    case 1: J.W = p.in[4]; J.ldw = 6160; J.c0 = 2048; J.nc = 1024; J.dst = trw0; J.gain = p.in[2]; break;
    case 2: J.W = p.in[4]; J.ldw = 6160; J.c0 = 3072; J.nc = 512; J.dst = natw0 + (size_t)C_QML * DM; J.gain = p.in[2]; break;
    case 3: J.W = p.in[4]; J.ldw = 6160; J.c0 = 3584; J.nc = 512; J.dst = natw0 + (size_t)C_KML * DM; J.gain = p.in[2]; J.cs = 0.08838834764831845f; break;
    case 4: J.W = p.in[4]; J.ldw = 6160; J.c0 = 4096; J.nc = 2048; J.dst = natw0 + (size_t)C_VML * DM; J.gain = p.in[2]; break;
    case 5: J.W = p.in[4]; J.ldw = 6160; J.c0 = 6144; J.nc = 16; J.dst = natw0 + (size_t)C_GML * DM; J.gain = p.in[2]; break;
    case 6: J.W = p.in[10]; J.ldw = 2048; J.c0 = 0; J.nc = 2048; J.dst = (bf16_t*)(ws + OFF_W0 + W_OUT0); break;
    case 7: J.W = p.in[16]; J.ldw = FF2; J.c0 = 0; J.nc = FF2; J.dst = (bf16_t*)(ws + OFF_W0 + W_UP0); J.gain = p.in[3]; J.mode = 1; break;
    case 8: J.W = p.in[19]; J.K = FF; J.ldw = 2048; J.c0 = 0; J.nc = 2048; J.dst = (bf16_t*)(ws + OFF_W0 + W_DN0); J.ldd = FF; break;
    case 9: J.W = p.in[11]; J.ldw = 6176; J.c0 = 0; J.nc = 1024; J.dst = natw1; J.gain = p.in[2] + DM; J.cs = 0.0625f; break;
    case 10: J.W = p.in[11]; J.ldw = 6176; J.c0 = 1024; J.nc = 5120; J.dst = natw1 + (size_t)1024 * DM; J.gain = p.in[2] + DM; break;
    case 11: J.W = p.in[11]; J.ldw = 6176; J.c0 = 6144; J.nc = 32; J.dst = natw1 + (size_t)C_GLR * DM; J.gain = p.in[2] + DM; break;
    case 12: J.W = p.in[15]; J.ldw = 2048; J.c0 = 0; J.nc = 2048; J.dst = (bf16_t*)(ws + OFF_W1 + W_OUT1); break;
    case 13: J.W = p.in[16] + (size_t)DM * FF2; J.ldw = FF2; J.c0 = 0; J.nc = FF2; J.dst = (bf16_t*)(ws + OFF_W1 + W_UP1); J.gain = p.in[3] + DM; J.mode = 1; break;
    default: J.W = p.in[19] + (size_t)FF * DM; J.K = FF; J.ldw = 2048; J.c0 = 0; J.nc = 2048; J.dst = (bf16_t*)(ws + OFF_W1 + W_DN1); J.ldd = FF; break;
    }
    return J;
}
constexpr int NJOBS = 15;

__device__ __forceinline__ void p0_prologue(const Params& p, LAS unsigned char* lds, int wv) {
    const int tid = phase_tid(wv), lane = tid & 63, wave = tid >> 6;
    const int gw = blockIdx.x * 8 + wave, NGW = gridDim.x * 8;
    unsigned char* ws = p.ws;
    bf16_t* hb = (bf16_t*)(ws + OFF_HB) + (size_t)256 * DM;
    float* ssq0 = (float*)(ws + OFF_SSQ);
    float* hmeta = (float*)(ws + OFF_HMETA);
    for (int g = gw; g < M; g += NGW) {
        const int b = g >= T ? 1 : 0, t = g - b * T;
        const float* src = t < 16 ? p.in[1] + (size_t)t * DM : p.in[0] + ((size_t)b * SEQ + (t - 16)) * DM;
        float s = 0.f;
#pragma unroll
        for (int j = 0; j < 8; ++j) { const f32x4 v = *(const f32x4*)(src + 4 * lane + 256 * j);
            s += (v[0] * v[0] + v[1] * v[1]) + (v[2] * v[2] + v[3] * v[3]);
            u32x2 w; w.x = pk2(v[0], v[1]); w.y = pk2(v[2], v[3]); *(u32x2*)(hb + (size_t)g * DM + 4 * lane + 256 * j) = w;
            if (t < 16) *(f32x4*)(hmeta + (size_t)(b * 16 + t) * DM + 4 * lane + 256 * j) = v; }
        s = wave_sum(s);
        if (lane == 0) ssq0[g] = s;
    }
    for (int r = gw; r < 256 + (MPAD - M); r += NGW) { const long row = r < 256 ? (long)r - 256 : (long)M + (r - 256);
#pragma unroll
        for (int j = 0; j < 4; ++j) *(u32x4*)(hb + row * DM + 8 * lane + 512 * j) = (u32x4){0u, 0u, 0u, 0u}; }
    { bf16_t* natw0 = (bf16_t*)(ws + OFF_W0 + W_NAT0); bf16_t* natw1 = (bf16_t*)(ws + OFF_W1 + W_NAT1);
      const int z0 = NAT0 - 5136, z1 = NAT1 - 6176;
      for (int r = gw; r < z0 + z1; r += NGW) { bf16_t* rowp = r < z0 ? natw0 + (size_t)(5136 + r) * DM : natw1 + (size_t)(6176 + (r - z0)) * DM;
#pragma unroll
          for (int j = 0; j < 4; ++j) *(u32x4*)(rowp + 8 * lane + 512 * j) = (u32x4){0u, 0u, 0u, 0u}; } }
    LAS float* scr = (LAS float*)(lds + wave * 16640);
    for (int j = 0; j < NJOBS; ++j) {
        const Job J = get_job(p, j);
        const int nitems = (J.K / 64) * ((J.nc + 63) >> 6);
        for (int it = gw; it < nitems; it += NGW) conv_item(J, it, scr, lane);
    }
}

__device__ __forceinline__ void qknorm_phase(const Params& p, int wv) {
    const int tid = phase_tid(wv), lane = tid & 63, wave = tid >> 6;
    const int gw = blockIdx.x * 8 + wave, NGW = gridDim.x * 8;
    bf16_t* nat = (bf16_t*)(p.ws + OFF_NAT);
    const float qs = 0.08838834764831845f * LOG2E;
    for (int g = gw; g < M; g += NGW) {
#pragma unroll
        for (int j = 0; j < 4; ++j) {
            const int col = 8 * lane + 512 * j;
            u32x4 v = *(const u32x4*)(nat + (size_t)g * NAT0 + col);
            float f[8] = {bflo(v.x), bfhi(v.x), bflo(v.y), bfhi(v.y), bflo(v.z), bfhi(v.z), bflo(v.w), bfhi(v.w)};
            float s = 0.f;
#pragma unroll
            for (int e = 0; e < 8; ++e) s += f[e] * f[e];
            s += sxor(s, 1); s += sxor(s, 2); s += sxor(s, 4); s += sxor(s, 8);
            const float rs = rsqrtf(s * (1.0f / 128.0f) + EPS);
            const bool isq = col < 1024; const float* gn = (isq ? p.in[6] : p.in[7]) + (col & 127);
            const float sc = isq ? rs * qs : rs;
#pragma unroll
            for (int e = 0; e < 8; ++e) f[e] = f[e] * sc * gn[e];
            v.x = pk2(f[0], f[1]); v.y = pk2(f[2], f[3]); v.z = pk2(f[4], f[5]); v.w = pk2(f[6], f[7]);
            *(u32x4*)(nat + (size_t)g * NAT0 + col) = v;
        }
    }
}

constexpr int NA_UNITS = NB * 256 * 4 * 8 + NB * 8;
#define NA_KLOAD(DST_, I_) do { const int tb_ = (I_) < 8 ? b * T + 16 + (r0 + (I_)) * 64 + cs : b * T; \
        _Pragma("unroll") for (int tau = 0; tau < 2; ++tau) { const bf16_t* kp_ = kbase + (size_t)(tb_ + 8 * (jq >> 2) + 4 * tau + (jq & 3)) * NAT0; \
            _Pragma("unroll") for (int kk = 0; kk < 4; ++kk) DST_[tau * 4 + kk] = *(const bf16x8*)(kp_ + 32 * kk); } } while (0)
#define NA_SCORE(SRC_, I_) do { \
        _Pragma("unroll") for (int tau = 0; tau < 2; ++tau) { f32x4 a_ = (f32x4){0.f, 0.f, 0.f, 0.f}; \
            _Pragma("unroll") for (int kk = 0; kk < 4; ++kk) a_ = mfma16(SRC_[tau * 4 + kk], qf[kk], a_); \
            _Pragma("unroll") for (int rho = 0; rho < 4; ++rho) { float s_; \
                if ((I_) < 8) { const int kc = cs + 8 * q + 4 * tau + rho; const bool ok = (kc >= c0) && (kc < c0 + 16); \
                    int dc = kc - qc + 15; dc = dc < 0 ? 0 : (dc > 30 ? 30 : dc); const int dr = r0 - r + (I_) + 7; \
                    s_ = ok ? a_[rho] + rb[dr * 31 + dc] : -INFINITY; } \
                else { s_ = (q < 2) ? a_[rho] : -INFINITY; } \
                a_[rho] = s_; mx = fmaxf(mx, s_); } \
            sc[I_][tau] = a_; } } while (0)
#define NA_VLOAD(DST_, I_) do { const int tb_ = (I_) < 8 ? b * T + 16 + (r0 + (I_)) * 64 + cs : b * T; \
        const bf16_t* vp_ = vt + (size_t)(h * 128 + jq) * MPAD + tb_ + 8 * q; \
        _Pragma("unroll") for (int dt = 0; dt < 8; ++dt) DST_[dt] = *(const bf16x8*)(vp_ + (size_t)(16 * dt) * MPAD); } while (0)
#define NA_PV(SRC_, I_) do { float pv_[8]; \
        _Pragma("unroll") for (int tau = 0; tau < 2; ++tau) \
            _Pragma("unroll") for (int rho = 0; rho < 4; ++rho) { const float e_ = __builtin_amdgcn_exp2f(sc[I_][tau][rho] - mx); pv_[4 * tau + rho] = e_; sum += e_; } \
        u32x4 pw_; pw_.x = pk2(pv_[0], pv_[1]); pw_.y = pk2(pv_[2], pv_[3]); pw_.z = pk2(pv_[4], pv_[5]); pw_.w = pk2(pv_[6], pv_[7]); \
        const bf16x8 pf_ = __builtin_bit_cast(bf16x8, pw_); \
        _Pragma("unroll") for (int dt = 0; dt < 8; ++dt) o[dt] = mfma16(SRC_[dt], pf_, o[dt]); } while (0)
__device__ __forceinline__ void na_unit(const Params& p, int id, int lane, const LAS float* rbt) {
    const bf16_t* nat = (const bf16_t*)(p.ws + OFF_NAT);
    const bf16_t* vt = (const bf16_t*)(p.ws + OFF_TR);
    bf16_t* mix = (bf16_t*)(p.ws + OFF_MIX);
    const int jq = lane & 15, q = lane >> 4;
    int b, h, r = 0, j = 0, r0 = 0, cs = 0, qtok; bool meta;
    if (id < NB * 256 * 4 * 8) { h = id & 7; j = (id >> 3) & 3; r = (id >> 5) & 255; b = id >> 13;
        r0 = r - 4; r0 = r0 < 0 ? 0 : (r0 > 248 ? 248 : r0); cs = 16 * j - 8; cs = cs < 0 ? 0 : (cs > 32 ? 32 : cs);
        qtok = b * T + 16 + r * 64 + 16 * j; meta = false; }
    else { const int m = id - NB * 256 * 4 * 8; h = m & 7; b = m >> 3; qtok = b * T; meta = true; }
    bf16x8 qf[4];
    { const bf16_t* qp = nat + (size_t)(qtok + jq) * NAT0 + C_QNA + h * 128 + 8 * q;
#pragma unroll
      for (int kk = 0; kk < 4; ++kk) qf[kk] = *(const bf16x8*)(qp + 32 * kk); }
    f32x4 sc[9][2];
    const bf16_t* kbase = nat + C_KNA + h * 128 + 8 * q;
    const LAS float* rb = rbt + h * (15 * 31);
    const int qc = 16 * j + jq; int c0 = qc - 8; c0 = c0 < 0 ? 0 : (c0 > 48 ? 48 : c0);
    float mx = -INFINITY, sum = 0.f;
    f32x4 o[8];
#pragma unroll
    for (int dt = 0; dt < 8; ++dt) o[dt] = (f32x4){0.f, 0.f, 0.f, 0.f};
    bf16x8 fa[8], fb[8];
    if (!meta) {
        NA_KLOAD(fa, 0);
        NA_KLOAD(fb, 1); NA_SCORE(fa, 0);
        NA_KLOAD(fa, 2); NA_SCORE(fb, 1);
        NA_KLOAD(fb, 3); NA_SCORE(fa, 2);
        NA_KLOAD(fa, 4); NA_SCORE(fb, 3);
        NA_KLOAD(fb, 5); NA_SCORE(fa, 4);
        NA_KLOAD(fa, 6); NA_SCORE(fb, 5);
        NA_KLOAD(fb, 7); NA_SCORE(fa, 6);
        NA_KLOAD(fa, 8); NA_SCORE(fb, 7);
        NA_VLOAD(fb, 0); NA_SCORE(fa, 8);
        mx = fmaxf(mx, sxor(mx, 16)); mx = fmaxf(mx, sxor(mx, 32));
        NA_VLOAD(fa, 1); NA_PV(fb, 0);
        NA_VLOAD(fb, 2); NA_PV(fa, 1);
        NA_VLOAD(fa, 3); NA_PV(fb, 2);
        NA_VLOAD(fb, 4); NA_PV(fa, 3);
        NA_VLOAD(fa, 5); NA_PV(fb, 4);
        NA_VLOAD(fb, 6); NA_PV(fa, 5);
        NA_VLOAD(fa, 7); NA_PV(fb, 6);
        NA_VLOAD(fb, 8); NA_PV(fa, 7);
        NA_PV(fb, 8);
    } else {
        NA_KLOAD(fa, 8); NA_VLOAD(fb, 8); NA_SCORE(fa, 8);
        mx = fmaxf(mx, sxor(mx, 16)); mx = fmaxf(mx, sxor(mx, 32));
        NA_PV(fb, 8);
    }
    sum += sxor(sum, 16); sum += sxor(sum, 32);
    const float inv = 1.0f / sum;
    bf16_t* op = mix + (size_t)(qtok + jq) * DM + h * 128 + 4 * q;
#pragma unroll
    for (int dt = 0; dt < 8; ++dt) { u32x2 w; w.x = pk2(o[dt][0] * inv, o[dt][1] * inv); w.y = pk2(o[dt][2] * inv, o[dt][3] * inv); *(u32x2*)(op + 16 * dt) = w; }
}
__device__ __forceinline__ void na_phase(const Params& p, LAS unsigned char* lds, unsigned* ctr, int wv) {
    const int tid = phase_tid(wv), lane = tid & 63;
    LAS float* rbt = (LAS float*)lds;
    __syncthreads();
    for (int i = tid; i < 8 * 15 * 31; i += 512) rbt[i] = p.in[8][i] * LOG2E;
    __syncthreads();
    for (;;) {
        int id = 0;
        if (lane == 0) id = (int)atomicAdd(ctr, 1u);
        id = __builtin_amdgcn_readfirstlane(id);
        if (id >= NA_UNITS) break;
        na_unit(p, id, lane, rbt);
    }
}

typedef short v4i16_t __attribute__((ext_vector_type(4)));
__device__ __forceinline__ bf16x8 gather8_tr(const LAS bf16_t* tile, int row0, int stride, int col0, int lane) {
    const int qq = (lane & 15) >> 2, pp = lane & 3;
    const LAS bf16_t* a0 = tile + (row0 + qq) * stride + col0 + 4 * pp;
    const v4i16_t lo = __builtin_amdgcn_ds_read_tr16_b64_v4i16((LAS v4i16_t*)a0);
    const v4i16_t hi = __builtin_amdgcn_ds_read_tr16_b64_v4i16((LAS v4i16_t*)(a0 + 4 * stride));
    return (bf16x8){lo[0], lo[1], lo[2], lo[3], hi[0], hi[1], hi[2], hi[3]};
}
__device__ __forceinline__ bf16x8 gather8(const LAS bf16_t* ptr, int stride) {
    bf16x8 r;
#pragma unroll
    for (int e = 0; e < 8; ++e) r[e] = (short)ptr[e * stride];
    return r;
}
constexpr size_t GA_STRIDE = (size_t)8 * MPAD;
constexpr size_t OFF_PT = OFF_TR + 65 * MiB;
static_assert(OFF_PT + (size_t)16 * 257 * 8192 <= 1000 * MiB, "map");
__device__ __forceinline__ void ml_pre(const Params& p, LAS unsigned char* lds, int wv) {
    const int tid = phase_tid(wv), lane = tid & 63, w = wv, jq = lane & 15, q = lane >> 4;
    const bf16_t* nat = (const bf16_t*)(p.ws + OFF_NAT);
    float* ga = (float*)(p.ws + OFF_ELAST);
    bf16_t* pt_out = (bf16_t*)(p.ws + OFF_PT);
    LAS bf16_t* Qs = (LAS bf16_t*)lds; LAS bf16_t* Ks = (LAS bf16_t*)(lds + 17408); LAS float* gl = (LAS float*)(lds + 34816);
    for (int unit = blockIdx.x; unit < NB * 4 * 257; unit += gridDim.x) {
        const int ci = unit % 257, r = unit / 257, h = r & 3, b = r >> 2;
        const int g0 = ci == 0 ? b * T : b * T + 16 + 64 * (ci - 1), c = ci == 0 ? 16 : 64;
#pragma unroll
        for (int i = 0; i < 2; ++i) { const int u = tid + 512 * i, row = u >> 4, oc = u & 15;
            u32x4 vq = (u32x4){0u, 0u, 0u, 0u}, vk = vq;
            if (row < c) { const bf16_t* rp = nat + (size_t)(g0 + row) * NAT0 + h * 128 + 8 * oc; vq = *(const u32x4*)(rp + C_QML); vk = *(const u32x4*)(rp + C_KML); }
            *(LAS u32x4*)(Qs + row * 136 + 8 * oc) = vq; *(LAS u32x4*)(Ks + row * 136 + 8 * oc) = vk; }
        if (w < 2) { const int dir = w; const bool valid = lane < c;
            float ig = -INFINITY, lf = 0.f;
            if (valid) { const bf16_t* gp = nat + (size_t)(g0 + lane) * NAT0 + C_GML;
                ig = bf1(gp[(2 * dir) * 4 + h]) + p.in[5][(2 * dir) * 4 + h];
                lf = log_sigmoid(bf1(gp[(2 * dir + 1) * 4 + h]) + p.in[5][(2 * dir + 1) * 4 + h]); }
            float bc = lf;
            if (dir == 0) {
#pragma unroll
                for (int o = 1; o < 64; o <<= 1) { const float t = sup(bc, o); if (lane >= o) bc += t; }
            } else {
#pragma unroll
                for (int o = 1; o < 64; o <<= 1) { const float t = sdown(bc, o); if (lane + o < 64) bc += t; }
            }
            const float a = valid ? ig - bc : -INFINITY;
            float rm = a;
            if (dir == 0) {
#pragma unroll
                for (int o = 1; o < 64; o <<= 1) { const float t = sup(rm, o); if (lane >= o) rm = fmaxf(rm, t); }
            } else {
#pragma unroll
                for (int o = 1; o < 64; o <<= 1) { const float t = sdown(rm, o); if (lane + o < 64) rm = fmaxf(rm, t); }
            }
            gl[dir * 128 + lane] = a; gl[dir * 128 + 64 + lane] = rm;
            if (valid) { const size_t o = (size_t)(dir * 4 + h) * MPAD + g0 + lane; ga[o] = a; ga[GA_STRIDE + o] = rm; ga[2 * GA_STRIDE + o] = bc; }
        }
        __syncthreads();
        {
            const int si = w & 3, tp = w >> 2;
            f32x4 a0 = (f32x4){0.f, 0.f, 0.f, 0.f}, a1 = a0;
#pragma unroll
            for (int kk = 0; kk < 4; ++kk) { const bf16x8 af = *(const LAS bf16x8*)(Ks + (16 * si + jq) * 136 + 32 * kk + 8 * q);
                a0 = mfma16(af, *(const LAS bf16x8*)(Qs + (16 * (2 * tp) + jq) * 136 + 32 * kk + 8 * q), a0);
                a1 = mfma16(af, *(const LAS bf16x8*)(Qs + (16 * (2 * tp + 1) + jq) * 136 + 32 * kk + 8 * q), a1); }
#pragma unroll
            for (int dir = 0; dir < 2; ++dir) {
                const f32x4 av4 = *(const LAS f32x4*)(gl + dir * 128 + 16 * si + 4 * q);
                bf16_t* po = pt_out + ((size_t)((dir * 4 + h) * 2 + b) * 257 + ci) * 4096;
#pragma unroll
                for (int tt = 0; tt < 2; ++tt) { const int t = 16 * (2 * tp + tt) + jq; const f32x4 a = tt == 0 ? a0 : a1; const float rmt = gl[dir * 128 + 64 + t]; float pv[4];
#pragma unroll
                    for (int rho = 0; rho < 4; ++rho) { const int s = 16 * si + 4 * q + rho;
                        const bool ok = (dir == 0 ? s <= t : s >= t) && s < c && t < c;
                        pv[rho] = ok ? __expf(av4[rho] - rmt) * a[rho] : 0.f; }
                    u32x2 wv2; wv2.x = pg8::cvt_pk_bf16(pv[0], pv[1]); wv2.y = pg8::cvt_pk_bf16(pv[2], pv[3]);
                    *(u32x2*)(po + t * 64 + 16 * si + 4 * q) = wv2; }
            }
        }
        __syncthreads();
    }
}
__device__ __forceinline__ void mlstm_scan(const Params& p, LAS unsigned char* lds, int idx, int wv) {
    const int tid = phase_tid(wv), lane = tid & 63, w = wv, jq = lane & 15, q = lane >> 4;
    const int sl = idx & 7, dir = (idx >> 3) & 1, h = (idx >> 4) & 3, b = idx >> 6;
    const bf16_t* nat = (const bf16_t*)(p.ws + OFF_NAT);
    const float* ga = (const float*)(p.ws + OFF_ELAST) + (size_t)(dir * 4 + h) * MPAD;
    const bf16_t* ptb = (const bf16_t*)(p.ws + OFF_PT) + (size_t)((dir * 4 + h) * 2 + b) * 257 * 4096;
    bf16_t* outp = (bf16_t*)(p.ws + OFF_HB) + (size_t)256 * DM + (size_t)dir * MPAD * 1024;
    constexpr int O_K = 17408, O_VT = 34816, O_VW = 39424, O_P = 46336, O_G = 55552, BUFB = 56064;
    constexpr int O_CT = 2 * BUFB, CTB = 48 * 136 * 2;
    LAS float* mch = (LAS float*)(lds + O_CT + 2 * CTB);
    LAS float* tmpf = mch + 260;
    for (int i = tid; i < 2 * CTB / 4; i += 512) ((LAS unsigned*)(lds + O_CT))[i] = 0u;
    for (int i = tid; i < 2 * 16 * 72 / 2; i += 512) { const int bb = i / (16 * 72 / 2), j = i % (16 * 72 / 2); ((LAS unsigned*)(lds + bb * BUFB + O_VW + 32 * 144))[j] = 0u; }
    if (tid < 257) { const int n = tid, ci = dir == 0 ? n : (n == 256 ? 0 : 256 - n);
        const int g0 = ci == 0 ? b * T : b * T + 16 + 64 * (ci - 1), c = ci == 0 ? 16 : 64;
        const int lastt = dir == 0 ? g0 + c - 1 : g0;
        tmpf[n] = ga[2 * GA_STRIDE + lastt]; tmpf[260 + n] = ga[GA_STRIDE + lastt]; }
    __syncthreads();
    if (tid == 0) { float m = 0.f; for (int n = 0; n < 257; ++n) { mch[n] = m; m = tmpf[n] + fmaxf(m, tmpf[260 + n]); } }
    f32x4 cst[3] = {(f32x4){0.f, 0.f, 0.f, 0.f}, (f32x4){0.f, 0.f, 0.f, 0.f}, (f32x4){0.f, 0.f, 0.f, 0.f}};
    u32x4 rq[2][2], rk[2][2], rv[2], rp[2]; float rg0[2], rg1[2], rg2[2], rgm[2];
    rv[0] = (u32x4){0u, 0u, 0u, 0u}; rv[1] = rv[0]; rg0[0] = rg0[1] = 0.f; rg1[0] = rg1[1] = 0.f; rg2[0] = rg2[1] = 0.f; rgm[0] = rgm[1] = 0.f;
#define ML_CHUNK(n_, g0_, c_, ci_) do { ci_ = dir == 0 ? (n_) : ((n_) == 256 ? 0 : 256 - (n_)); \
        if (ci_ == 0) { g0_ = b * T; c_ = 16; } else { g0_ = b * T + 16 + 64 * (ci_ - 1); c_ = 64; } } while (0)
#define ML_ISSUE(n_, S_) do { int g0i, ci_i, cix; ML_CHUNK(n_, g0i, ci_i, cix); \
        _Pragma("unroll") for (int i = 0; i < 2; ++i) { const int u = tid + 512 * i, row = u >> 4, oc = u & 15; \
            if (row < ci_i) { const bf16_t* rp_ = nat + (size_t)(g0i + row) * NAT0 + h * 128 + 8 * oc; rq[S_][i] = *(const u32x4*)(rp_ + C_QML); rk[S_][i] = *(const u32x4*)(rp_ + C_KML); } \
            else { rq[S_][i] = (u32x4){0u, 0u, 0u, 0u}; rk[S_][i] = rq[S_][i]; } } \
        rp[S_] = *(const u32x4*)(ptb + (size_t)cix * 4096 + 8 * tid); \
        if (tid < 256) { const int row = tid >> 2, pt = tid & 3; \
            if (row < ci_i) { rv[S_] = *(const u32x4*)(nat + (size_t)(g0i + row) * NAT0 + C_VML + h * 256 + sl * 32 + 8 * pt); rg0[S_] = ga[g0i + row]; } \
            else { rv[S_] = (u32x4){0u, 0u, 0u, 0u}; rg0[S_] = -INFINITY; } \
            rgm[S_] = ga[GA_STRIDE + (dir == 0 ? g0i + ci_i - 1 : g0i)]; } \
        if (tid < 64) { if (tid < ci_i) { rg1[S_] = ga[GA_STRIDE + g0i + tid]; rg2[S_] = ga[2 * GA_STRIDE + g0i + tid]; } else { rg1[S_] = -INFINITY; rg2[S_] = 0.f; } } } while (0)
#define ML_STAGE(n_, S_) do { LAS unsigned char* B_ = lds + ((n_) & 1) * BUFB; \
        _Pragma("unroll") for (int i = 0; i < 2; ++i) { const int u = tid + 512 * i, row = u >> 4, oc = u & 15; \
            *(LAS u32x4*)((LAS bf16_t*)B_ + row * 136 + 8 * oc) = rq[S_][i]; *(LAS u32x4*)((LAS bf16_t*)(B_ + O_K) + row * 136 + 8 * oc) = rk[S_][i]; } \
        *(LAS u32x4*)((LAS bf16_t*)(B_ + O_P) + (tid >> 3) * 72 + 8 * (tid & 7)) = rp[S_]; \
        if (tid < 256) { const int row = tid >> 2, pt = tid & 3; const float wt = __expf(rg0[S_] - fmaxf(mch[n_], rgm[S_])); \
            LAS bf16_t* vt_ = (LAS bf16_t*)(B_ + O_VT) + (8 * pt) * 72 + row; LAS bf16_t* vw_ = (LAS bf16_t*)(B_ + O_VW) + (8 * pt) * 72 + row; \
            const unsigned vv_[4] = {rv[S_].x, rv[S_].y, rv[S_].z, rv[S_].w}; \
            _Pragma("unroll") for (int e = 0; e < 4; ++e) { const unsigned ww_ = pg8::cvt_pk_bf16(bflo(vv_[e]) * wt, bfhi(vv_[e]) * wt); \
                vt_[(2 * e) * 72] = (bf16_t)(vv_[e] & 0xffffu); vt_[(2 * e + 1) * 72] = (bf16_t)(vv_[e] >> 16); \
                vw_[(2 * e) * 72] = (bf16_t)(ww_ & 0xffffu); vw_[(2 * e + 1) * 72] = (bf16_t)(ww_ >> 16); } \
            if (pt == 0) ((LAS bf16_t*)(B_ + O_VW))[32 * 72 + row] = (bf16_t)(pg8::cvt_pk_bf16(wt, wt) & 0xffffu); } \
        if (tid < 64) { LAS float* gv_ = (LAS float*)(B_ + O_G); gv_[tid] = rg1[S_]; gv_[64 + tid] = rg2[S_]; } } while (0)
#define ML_STEP(n_, P_) do { \
        int g0, c, ci; ML_CHUNK(n_, g0, c, ci); (void)ci; \
        LAS unsigned char* Bc = lds + (P_) * BUFB; \
        LAS bf16_t* Qs = (LAS bf16_t*)Bc; LAS bf16_t* Ks = (LAS bf16_t*)(Bc + O_K); LAS bf16_t* VT = (LAS bf16_t*)(Bc + O_VT); LAS bf16_t* VW = (LAS bf16_t*)(Bc + O_VW); \
        LAS bf16_t* Ps = (LAS bf16_t*)(Bc + O_P); LAS float* gv = (LAS float*)(Bc + O_G); \
        LAS bf16_t* CTc = (LAS bf16_t*)(lds + O_CT + (P_) * CTB); LAS bf16_t* CTn = (LAS bf16_t*)(lds + O_CT + ((P_) ^ 1) * CTB); \
        if ((n_) + 1 < 257) ML_STAGE((n_) + 1, (P_) ^ 1); \
        if ((n_) + 3 < 257) ML_ISSUE((n_) + 3, (P_) ^ 1); \
        const float m = mch[n_]; \
        const float mlast = fmaxf(m, dir == 0 ? gv[c - 1] : gv[0]); \
        const int oei = w & 1, oti = w >> 1; \
        { \
            f32x4 d1 = (f32x4){0.f, 0.f, 0.f, 0.f}, d2 = d1, dn = d1, dp = d1; \
            const bf16x8 ones = (bf16x8){0x3f80, 0x3f80, 0x3f80, 0x3f80, 0x3f80, 0x3f80, 0x3f80, 0x3f80}; \
        _Pragma("unroll") \
            for (int kk = 0; kk < 4; ++kk) { const bf16x8 qfr = *(const LAS bf16x8*)(Qs + (16 * oti + jq) * 136 + 32 * kk + 8 * q); \
                d1 = mfma16(*(const LAS bf16x8*)(CTc + (16 * oei + jq) * 136 + 32 * kk + 8 * q), qfr, d1); \
                dn = mfma16(*(const LAS bf16x8*)(CTc + 32 * 136 + 32 * kk + 8 * q), qfr, dn); } \
        _Pragma("unroll") \
            for (int ks = 0; ks < 2; ++ks) { const bf16x8 pfr = *(const LAS bf16x8*)(Ps + (16 * oti + jq) * 72 + 32 * ks + 8 * q); \
                d2 = mfma16(*(const LAS bf16x8*)(VT + (16 * oei + jq) * 72 + 32 * ks + 8 * q), pfr, d2); \
                dp = mfma16(ones, pfr, dp); } \
            const int t = 16 * oti + jq; \
            if (t < c) { const float rmt = gv[t], mtt = fmaxf(m, rmt); const float wp = __expf(m - mtt), rr = __expf(rmt - mtt), emt = __expf(-(gv[64 + t] + mtt)); \
                const float den = wp * dn[0] + rr * dp[0]; const float iv = __builtin_amdgcn_rcpf(fmaxf(fabsf(den), emt)); u32x2 wv2; \
                wv2.x = pg8::cvt_pk_bf16((wp * d1[0] + rr * d2[0]) * iv, (wp * d1[1] + rr * d2[1]) * iv); wv2.y = pg8::cvt_pk_bf16((wp * d1[2] + rr * d2[2]) * iv, (wp * d1[3] + rr * d2[3]) * iv); \
                *(u32x2*)(outp + (size_t)(g0 + t) * 1024 + h * 256 + sl * 32 + 16 * oei + 4 * q) = wv2; } \
        } \
        { const float wst = __expf(m - mlast); \
          f32x4 dacc[3] = {(f32x4){0.f, 0.f, 0.f, 0.f}, (f32x4){0.f, 0.f, 0.f, 0.f}, (f32x4){0.f, 0.f, 0.f, 0.f}}; \
        _Pragma("unroll") \
          for (int ks = 0; ks < 2; ++ks) { const bf16x8 af = gather8_tr(Ks, 32 * ks + 8 * q, 136, 16 * w, lane); \
        _Pragma("unroll") \
              for (int ej = 0; ej < 3; ++ej) dacc[ej] = mfma16(af, *(const LAS bf16x8*)(VW + (16 * ej + jq) * 72 + 32 * ks + 8 * q), dacc[ej]); } \
        _Pragma("unroll") \
          for (int ej = 0; ej < 3; ++ej) { cst[ej] = cst[ej] * wst + dacc[ej]; u32x2 wv2; wv2.x = pg8::cvt_pk_bf16(cst[ej][0], cst[ej][1]); wv2.y = pg8::cvt_pk_bf16(cst[ej][2], cst[ej][3]); \
              *(LAS u32x2*)(CTn + (16 * ej + jq) * 136 + 16 * w + 4 * q) = wv2; } } \
        BAR_LDS(); \
    } while (0)
    __syncthreads();
    ML_ISSUE(0, 0);
    ML_STAGE(0, 0);
    ML_ISSUE(1, 1);
    ML_ISSUE(2, 0);
    __syncthreads();
    for (int n = 0; n < 256; n += 2) { ML_STEP(n, 0); ML_STEP(n + 1, 1); }
    ML_STEP(256, 0);
    __syncthreads();
#undef ML_CHUNK
#undef ML_ISSUE
#undef ML_STAGE
#undef ML_STEP
}

__device__ __forceinline__ void post0_phase(const Params& p, int wv) {
    const int tid = phase_tid(wv), lane = tid & 63, wave = tid >> 6;
    const int gw = blockIdx.x * 8 + wave, NGW = gridDim.x * 8;
    const bf16_t* hf = (const bf16_t*)(p.ws + OFF_HB) + (size_t)256 * DM; const bf16_t* hbw = hf + (size_t)MPAD * 1024;
    const bf16_t* nat = (const bf16_t*)(p.ws + OFF_NAT);
    bf16_t* mix = (bf16_t*)(p.ws + OFF_MIX);
    for (int it = gw; it < M * 4; it += NGW) { const int g = it >> 2, hh = it & 3, col = hh * 256 + 4 * lane;
        const u32x2 a = *(const u32x2*)(hf + (size_t)g * 1024 + col), c = *(const u32x2*)(hbw + (size_t)g * 1024 + col), ov = *(const u32x2*)(nat + (size_t)g * NAT0 + C_OML + col);
        float v[4] = {bflo(a.x) + bflo(c.x), bfhi(a.x) + bfhi(c.x), bflo(a.y) + bflo(c.y), bfhi(a.y) + bfhi(c.y)};
        const float o[4] = {bflo(ov.x), bfhi(ov.x), bflo(ov.y), bfhi(ov.y)};
        const float s = wave_sum((v[0] * v[0] + v[1] * v[1]) + (v[2] * v[2] + v[3] * v[3]));
        const float rs = rsqrtf(s * (1.0f / 256.0f) + EPS); const f32x4 gn = *(const f32x4*)(p.in[9] + col);
#pragma unroll
        for (int e = 0; e < 4; ++e) v[e] = v[e] * rs * gn[e] * __builtin_amdgcn_rcpf(1.0f + __expf(-o[e]));
        u32x2 wv; wv.x = pk2(v[0], v[1]); wv.y = pk2(v[2], v[3]); *(u32x2*)(mix + (size_t)g * DM + 1024 + col) = wv; }
}

__device__ __forceinline__ void gla_pre(const Params& p, LAS unsigned char* lds, int wv) {
    const int tid = phase_tid(wv);
    bf16_t* nat = (bf16_t*)(p.ws + OFF_NAT);
    bf16_t* qb = (bf16_t*)(p.ws + OFF_W0); bf16_t* kb = qb + (size_t)MPAD * 1024;
    float* elast = (float*)(p.ws + OFF_ELAST);
    LAS bf16_t* qs = (LAS bf16_t*)lds; LAS bf16_t* ks = (LAS bf16_t*)(lds + 32768); LAS float* lrs = (LAS float*)(lds + 65536);
    for (int unit = blockIdx.x; unit < NB * 257 * 4; unit += gridDim.x) {
        const int h = unit & 3, ci = (unit >> 2) % 257, b = (unit >> 2) / 257;
        const int g0 = ci == 0 ? b * T : b * T + 16 + 64 * (ci - 1), c = ci == 0 ? 16 : 64;
#pragma unroll
        for (int i = 0; i < 4; ++i) { const int u = tid + 512 * i, row = u >> 5, oc = u & 31;
            u32x4 vq = (u32x4){0u, 0u, 0u, 0u}, vk = vq;
            if (row < c) { const bf16_t* rp = nat + (size_t)(g0 + row) * NAT1 + h * 256 + 8 * oc; vq = *(const u32x4*)(rp + C_GQ); vk = *(const u32x4*)(rp + C_GK); }
            *(LAS u32x4*)(qs + row * 256 + 8 * oc) = vq; *(LAS u32x4*)(ks + row * 256 + 8 * oc) = vk; }
        { const int row = tid >> 3, c4 = (tid & 7) * 4;
          if (row < c) { const u32x2 v = *(const u32x2*)(nat + (size_t)(g0 + row) * NAT1 + C_GLR + c4);
              lrs[row * 32 + c4] = bflo(v.x); lrs[row * 32 + c4 + 1] = bfhi(v.x); lrs[row * 32 + c4 + 2] = bflo(v.y); lrs[row * 32 + c4 + 3] = bfhi(v.y); } }
        __syncthreads();
        { const int d = tid & 255, dr = tid >> 8;
          float gu[16];
#pragma unroll
          for (int r = 0; r < 16; ++r) gu[r] = p.in[12][(size_t)(dr * 16 + r) * 1024 + h * 256 + d];
          const float gb = p.in[13][dr * 1024 + h * 256 + d];
          bf16_t* qo = dr == 0 ? nat + C_GQ : qb; bf16_t* ko = dr == 0 ? nat + C_GK : kb; const int ldo = dr == 0 ? NAT1 : 1024;
          float run = 0.f;
          for (int st = 0; st < c; ++st) { const int s = dr == 0 ? st : c - 1 - st;
              float x = gb;
#pragma unroll
              for (int r = 0; r < 16; ++r) x += lrs[s * 32 + dr * 16 + r] * gu[r];
              run += log_sigmoid(x) * (1.0f / 16.0f);
              const float E = __expf(run);
              const float qv = bf1(qs[s * 256 + d]) * E, kv = bf1(ks[s * 256 + d]) * __builtin_amdgcn_rcpf(E);
              qo[(size_t)(g0 + s) * ldo + h * 256 + d] = (bf16_t)f2bf(qv); ko[(size_t)(g0 + s) * ldo + h * 256 + d] = (bf16_t)f2bf(kv); }
          elast[((size_t)((dr * 2 + b) * 257 + ci) * 4 + h) * 256 + d] = __expf(run); }
        __syncthreads();
    }
}
__device__ __forceinline__ void gla_pre2(const Params& p, LAS unsigned char* lds, int wv) {
    const int tid = phase_tid(wv), lane = tid & 63, w = wv, jq = lane & 15, q = lane >> 4;
    const bf16_t* nat = (const bf16_t*)(p.ws + OFF_NAT);
    bf16_t* at_out = (bf16_t*)(p.ws + OFF_PT);
    LAS bf16_t* Qs = (LAS bf16_t*)lds; LAS bf16_t* Ks = (LAS bf16_t*)(lds + 33792);
    for (int unit = blockIdx.x; unit < 2 * NB * 257 * 4; unit += gridDim.x) {
        const int h = unit & 3, ci = (unit >> 2) % 257, r = (unit >> 2) / 257, b = r & 1, dir = r >> 1;
        const int g0 = ci == 0 ? b * T : b * T + 16 + 64 * (ci - 1), c = ci == 0 ? 16 : 64;
        const bf16_t* qsrc = dir == 0 ? nat + C_GQ : (const bf16_t*)(p.ws + OFF_W0);
        const bf16_t* ksrc = dir == 0 ? nat + C_GK : (const bf16_t*)(p.ws + OFF_W0) + (size_t)MPAD * 1024;
        const int ldq = dir == 0 ? NAT1 : 1024;
#pragma unroll
        for (int i = 0; i < 4; ++i) { const int u = tid + 512 * i, row = u >> 5, oc = u & 31;
            u32x4 vq = (u32x4){0u, 0u, 0u, 0u}, vk = vq;
            if (row < c) { const size_t off = (size_t)(g0 + row) * ldq + h * 256 + 8 * oc; vq = *(const u32x4*)(qsrc + off); vk = *(const u32x4*)(ksrc + off); }
            *(LAS u32x4*)(Qs + row * 264 + 8 * oc) = vq; *(LAS u32x4*)(Ks + row * 264 + 8 * oc) = vk; }
        __syncthreads();
        {
            const int si = w & 3, tp = w >> 2;
            f32x4 a0 = (f32x4){0.f, 0.f, 0.f, 0.f}, a1 = a0;
#pragma unroll
            for (int kk = 0; kk < 8; ++kk) { const bf16x8 af = *(const LAS bf16x8*)(Ks + (16 * si + jq) * 264 + 32 * kk + 8 * q);
                a0 = mfma16(af, *(const LAS bf16x8*)(Qs + (16 * (2 * tp) + jq) * 264 + 32 * kk + 8 * q), a0);
                a1 = mfma16(af, *(const LAS bf16x8*)(Qs + (16 * (2 * tp + 1) + jq) * 264 + 32 * kk + 8 * q), a1); }
            bf16_t* po = at_out + (size_t)unit * 4096;
#pragma unroll
            for (int tt = 0; tt < 2; ++tt) { const int t = 16 * (2 * tp + tt) + jq; const f32x4 a = tt == 0 ? a0 : a1; float pv[4];
#pragma unroll
                for (int rho = 0; rho < 4; ++rho) { const int s = 16 * si + 4 * q + rho;
                    const bool ok = (dir == 0 ? s <= t : s >= t) && s < c && t < c; pv[rho] = ok ? a[rho] : 0.f; }
                u32x2 wv2; wv2.x = pg8::cvt_pk_bf16(pv[0], pv[1]); wv2.y = pg8::cvt_pk_bf16(pv[2], pv[3]);
                *(u32x2*)(po + t * 64 + 16 * si + 4 * q) = wv2; }
        }
        __syncthreads();
    }
}
__device__ __forceinline__ void gla_scan(const Params& p, LAS unsigned char* lds, int idx, int wv) {
    const int tid = phase_tid(wv), lane = tid & 63, w = wv, jq = lane & 15, q = lane >> 4;
    const int sl = idx & 15, dir = (idx >> 4) & 1, h = (idx >> 5) & 3, b = idx >> 7;
    const bf16_t* nat = (const bf16_t*)(p.ws + OFF_NAT);
    const bf16_t* qsrc = dir == 0 ? nat + C_GQ : (const bf16_t*)(p.ws + OFF_W0);
    const bf16_t* ksrc = dir == 0 ? nat + C_GK : (const bf16_t*)(p.ws + OFF_W0) + (size_t)MPAD * 1024;
    const int lds_ = dir == 0 ? NAT1 : 1024;
    const float* elast = (const float*)(p.ws + OFF_ELAST);
    const bf16_t* atb = (const bf16_t*)(p.ws + OFF_PT);
    bf16_t* outp = dir == 0 ? (bf16_t*)(p.ws + OFF_HB) + (size_t)256 * DM : (bf16_t*)(p.ws + OFF_MIX);
    constexpr int O_VT = 33792, O_A = 38400, O_EL = 47616, BUFB = 48640;
    constexpr int O_ST = 2 * BUFB, STB = 32 * 264 * 2;
    for (int i = tid; i < 2 * STB / 4; i += 512) ((LAS unsigned*)(lds + O_ST))[i] = 0u;
    f32x4 sst[2][2];
#pragma unroll
    for (int a = 0; a < 2; ++a)
#pragma unroll
        for (int e = 0; e < 2; ++e) sst[a][e] = (f32x4){0.f, 0.f, 0.f, 0.f};
    const int oei = w & 1, oti = w >> 1;
    u32x4 rk[2][4], rv[2], ra[2]; float rel[2];
    bf16x8 qn[2][8];
    rv[0] = (u32x4){0u, 0u, 0u, 0u}; rv[1] = rv[0]; rel[0] = 0.f; rel[1] = 0.f;
#define GLA_CHUNK(n_, g0_, c_, ci_) do { ci_ = dir == 0 ? (n_) : ((n_) == 256 ? 0 : 256 - (n_)); \
        if (ci_ == 0) { g0_ = b * T; c_ = 16; } else { g0_ = b * T + 16 + 64 * (ci_ - 1); c_ = 64; } } while (0)
#define GLA_ISSUE(n_, S_) do { int g0i, ci_i, cci; GLA_CHUNK(n_, g0i, ci_i, cci); \
        _Pragma("unroll") for (int i = 0; i < 4; ++i) { const int u = tid + 512 * i, row = u >> 5, oc = u & 31; \
            if (row < ci_i) rk[S_][i] = *(const u32x4*)(ksrc + (size_t)(g0i + row) * lds_ + h * 256 + 8 * oc); else rk[S_][i] = (u32x4){0u, 0u, 0u, 0u}; } \
        ra[S_] = *(const u32x4*)(atb + ((size_t)(((dir * 2 + b) * 257 + cci) * 4 + h)) * 4096 + 8 * tid); \
        if (tid < 256) { const int row = tid >> 2, pt = tid & 3; \
            rv[S_] = row < ci_i ? *(const u32x4*)(nat + (size_t)(g0i + row) * NAT1 + C_GV + h * 512 + sl * 32 + 8 * pt) : (u32x4){0u, 0u, 0u, 0u}; \
            rel[S_] = elast[((size_t)((dir * 2 + b) * 257 + cci) * 4 + h) * 256 + tid]; } } while (0)
#define GLA_QISSUE(n_, S_) do { int g0i, ci_i, cci; GLA_CHUNK(n_, g0i, ci_i, cci); (void)ci_i; (void)cci; \
        const bf16_t* qp_ = qsrc + (size_t)(g0i + 16 * oti + jq) * lds_ + h * 256 + 8 * q; \
        _Pragma("unroll") for (int kk = 0; kk < 8; ++kk) qn[S_][kk] = *(const bf16x8*)(qp_ + 32 * kk); } while (0)
#define GLA_STAGE(n_, S_) do { LAS unsigned char* B_ = lds + ((n_) & 1) * BUFB; \
        _Pragma("unroll") for (int i = 0; i < 4; ++i) { const int u = tid + 512 * i, row = u >> 5, oc = u & 31; *(LAS u32x4*)((LAS bf16_t*)B_ + row * 264 + 8 * oc) = rk[S_][i]; } \
        *(LAS u32x4*)((LAS bf16_t*)(B_ + O_A) + (tid >> 3) * 72 + 8 * (tid & 7)) = ra[S_]; \
        if (tid < 256) { const int row = tid >> 2, pt = tid & 3; LAS bf16_t* vt_ = (LAS bf16_t*)(B_ + O_VT) + (8 * pt) * 72 + row; \
            const unsigned vv_[4] = {rv[S_].x, rv[S_].y, rv[S_].z, rv[S_].w}; \
            _Pragma("unroll") for (int e = 0; e < 4; ++e) { vt_[(2 * e) * 72] = (bf16_t)(vv_[e] & 0xffffu); vt_[(2 * e + 1) * 72] = (bf16_t)(vv_[e] >> 16); } \
            ((LAS float*)(B_ + O_EL))[tid] = rel[S_]; } } while (0)
#define GLA_STEP(n_, P_) do { \
        int g0, c, ci; GLA_CHUNK(n_, g0, c, ci); (void)ci; \
        LAS unsigned char* Bc = lds + (P_) * BUFB; \
        LAS bf16_t* Ks = (LAS bf16_t*)Bc; LAS bf16_t* VT = (LAS bf16_t*)(Bc + O_VT); LAS bf16_t* As = (LAS bf16_t*)(Bc + O_A); LAS float* el = (LAS float*)(Bc + O_EL); \
        LAS bf16_t* STc = (LAS bf16_t*)(lds + O_ST + (P_) * STB); LAS bf16_t* STn = (LAS bf16_t*)(lds + O_ST + ((P_) ^ 1) * STB); \
        if ((n_) + 1 < 257) GLA_STAGE((n_) + 1, (P_) ^ 1); \
        if ((n_) + 3 < 257) GLA_ISSUE((n_) + 3, (P_) ^ 1); \
        f32x4 oa = (f32x4){0.f, 0.f, 0.f, 0.f}; \
        _Pragma("unroll") for (int kk = 0; kk < 8; ++kk) oa = mfma16(*(const LAS bf16x8*)(STc + (16 * oei + jq) * 264 + 32 * kk + 8 * q), qn[P_][kk], oa); \
        if ((n_) + 2 < 257) GLA_QISSUE((n_) + 2, P_); \
        _Pragma("unroll") for (int ks = 0; ks < 2; ++ks) oa = mfma16(*(const LAS bf16x8*)(VT + (16 * oei + jq) * 72 + 32 * ks + 8 * q), *(const LAS bf16x8*)(As + (16 * oti + jq) * 72 + 32 * ks + 8 * q), oa); \
        { const int t = 16 * oti + jq; \
          if (t < c) { u32x2 wv2; wv2.x = pg8::cvt_pk_bf16(oa[0], oa[1]); wv2.y = pg8::cvt_pk_bf16(oa[2], oa[3]); \
              *(u32x2*)(outp + (size_t)(g0 + t) * DM + h * 512 + sl * 32 + 16 * oei + 4 * q) = wv2; } } \
        bf16x8 vf[2][2]; \
        _Pragma("unroll") for (int ks = 0; ks < 2; ++ks) \
            _Pragma("unroll") for (int ej = 0; ej < 2; ++ej) vf[ks][ej] = *(const LAS bf16x8*)(VT + (16 * ej + jq) * 72 + 32 * ks + 8 * q); \
        _Pragma("unroll") for (int dd = 0; dd < 2; ++dd) { \
            f32x4 dl0 = (f32x4){0.f, 0.f, 0.f, 0.f}, dl1 = dl0; \
            _Pragma("unroll") for (int ks = 0; ks < 2; ++ks) { const bf16x8 af = gather8_tr(Ks, 32 * ks + 8 * q, 264, 16 * (2 * w + dd), lane); \
                dl0 = mfma16(af, vf[ks][0], dl0); dl1 = mfma16(af, vf[ks][1], dl1); } \
            const int d0 = 16 * (2 * w + dd) + 4 * q; const f32x4 ev = *(const LAS f32x4*)(el + d0); \
            sst[dd][0] = (sst[dd][0] + dl0) * ev; sst[dd][1] = (sst[dd][1] + dl1) * ev; \
            u32x2 w0; w0.x = pg8::cvt_pk_bf16(sst[dd][0][0], sst[dd][0][1]); w0.y = pg8::cvt_pk_bf16(sst[dd][0][2], sst[dd][0][3]); \
            u32x2 w1; w1.x = pg8::cvt_pk_bf16(sst[dd][1][0], sst[dd][1][1]); w1.y = pg8::cvt_pk_bf16(sst[dd][1][2], sst[dd][1][3]); \
            *(LAS u32x2*)(STn + (0 + jq) * 264 + d0) = w0; *(LAS u32x2*)(STn + (16 + jq) * 264 + d0) = w1; \
        } \
        BAR_LDS(); } while (0)
    __syncthreads();
    GLA_ISSUE(0, 0);
    GLA_STAGE(0, 0);
    GLA_ISSUE(1, 1);
    GLA_ISSUE(2, 0);
    GLA_QISSUE(0, 0);
    GLA_QISSUE(1, 1);
    __syncthreads();
    for (int n = 0; n < 256; n += 2) { GLA_STEP(n, 0); GLA_STEP(n + 1, 1); }
    GLA_STEP(256, 0);
    __syncthreads();
#undef GLA_CHUNK
#undef GLA_ISSUE
#undef GLA_QISSUE
#undef GLA_STAGE
#undef GLA_STEP
}
__device__ __forceinline__ void post1_phase(const Params& p, int wv) {
    const int tid = phase_tid(wv), lane = tid & 63, wave = tid >> 6;
    const int gw = blockIdx.x * 8 + wave, NGW = gridDim.x * 8;
    const bf16_t* of = (const bf16_t*)(p.ws + OFF_HB) + (size_t)256 * DM;
    bf16_t* mix = (bf16_t*)(p.ws + OFF_MIX);
    const bf16_t* nat = (const bf16_t*)(p.ws + OFF_NAT);
    for (int it = gw; it < M * 4; it += NGW) { const int g = it >> 2, hh = it & 3, col = hh * 512 + 8 * lane;
        const u32x4 a = *(const u32x4*)(of + (size_t)g * DM + col), c = *(const u32x4*)(mix + (size_t)g * DM + col), rv = *(const u32x4*)(nat + (size_t)g * NAT1 + C_GR + col);
        float v[8] = {bflo(a.x) + bflo(c.x), bfhi(a.x) + bfhi(c.x), bflo(a.y) + bflo(c.y), bfhi(a.y) + bfhi(c.y), bflo(a.z) + bflo(c.z), bfhi(a.z) + bfhi(c.z), bflo(a.w) + bflo(c.w), bfhi(a.w) + bfhi(c.w)};
        const float r[8] = {bflo(rv.x), bfhi(rv.x), bflo(rv.y), bfhi(rv.y), bflo(rv.z), bfhi(rv.z), bflo(rv.w), bfhi(rv.w)};
        float s = 0.f;
#pragma unroll
        for (int e = 0; e < 8; ++e) s += v[e] * v[e];
        s = wave_sum(s);
        const float rs = rsqrtf(s * (1.0f / 512.0f) + EPS);
        const float* gn = p.in[14] + col;
#pragma unroll
        for (int e = 0; e < 8; ++e) v[e] = v[e] * rs * gn[e] * r[e] * __builtin_amdgcn_rcpf(1.0f + __expf(-r[e]));
        u32x4 wv; wv.x = pk2(v[0], v[1]); wv.y = pk2(v[2], v[3]); wv.z = pk2(v[4], v[5]); wv.w = pk2(v[6], v[7]);
        *(u32x4*)(mix + (size_t)g * DM + col) = wv; }
}

__device__ __forceinline__ void tail_rows(LAS unsigned char* lds, const bf16_t* A, const bf16_t* Bt, int K, const pg8::EpiRes& E, int wv) {
    const int lane = lane_id_v(), jq = lane & 15, q = lane >> 4;
    LAS float* red = (LAS float*)lds;
    for (int j = blockIdx.x; j < 256; j += gridDim.x) {
        const int rt = j >> 7, ct = j & 127, g = 32768 + 16 * rt + jq, kw = K >> 3, k0 = wv * kw;
        const bf16_t* ap = A + (size_t)g * K + k0 + 8 * q; const bf16_t* bp = Bt + (size_t)(16 * ct + jq) * K + k0 + 8 * q;
        f32x4 acc = (f32x4){0.f, 0.f, 0.f, 0.f};
#pragma unroll 4
        for (int k = 0; k < kw; k += 32) acc = mfma16(*(const bf16x8*)(bp + k), *(const bf16x8*)(ap + k), acc);
        *(LAS f32x4*)(red + (wv * 64 + lane) * 4) = acc;
        __syncthreads();
        if (wv == 0) {
            f32x4 v = (f32x4){0.f, 0.f, 0.f, 0.f};
#pragma unroll
            for (int i = 0; i < 8; ++i) v += *(const LAS f32x4*)(red + (i * 64 + lane) * 4);
            const int b = 1, t = g - T, col = 16 * ct + 4 * q;
            const float* sp = E.srcx + ((size_t)b * SEQ + (t - 16)) * DM; float* dp = E.dstx + ((size_t)b * SEQ + (t - 16)) * DM;
            v += *(const f32x4*)(sp + col);
            *(f32x4*)(dp + col) = v;
            if (E.hb) { u32x2 w2; w2.x = pg8::cvt_pk_bf16(v[0], v[1]); w2.y = pg8::cvt_pk_bf16(v[2], v[3]); *(u32x2*)(E.hb + (size_t)g * DM + col) = w2; }
            float ss = (v[0] * v[0] + v[1] * v[1]) + (v[2] * v[2] + v[3] * v[3]);
            ss += sxor(ss, 16); ss += sxor(ss, 32);
            if (E.ssq && q == 0) atomicAdd(E.ssq + g, ss);
        }
        __syncthreads();
    }
}

constexpr size_t OFF_XBAR = 16 * 1024;
constexpr int LDS_XBST = LDS_BYTES - 16;
#define XB_TMO      128
#define XB_XCNT(j)  (256  + 64 * (j))
#define XB_XSUB(j)  (1280 + 64 * (j))
#define XB_XGEN(j)  (2304 + 64 * (j))
#define XB_TOP      3328
#define XB_TOPGEN   3392
#define XCD_BAR_WORDS 3456
#define XB_SPIN_CAP (1u << 18)

__device__ __forceinline__ unsigned xb_ld(unsigned* p)              { return __hip_atomic_load(p, __ATOMIC_RELAXED, __HIP_MEMORY_SCOPE_AGENT); }
__device__ __forceinline__ unsigned xb_add(unsigned* p, unsigned v) { return __hip_atomic_fetch_add(p, v, __ATOMIC_RELAXED, __HIP_MEMORY_SCOPE_AGENT); }
__device__ __forceinline__ unsigned xb_xcc_id() { return (unsigned)__builtin_amdgcn_s_getreg((3 << 11) | 20) & 0xFu; }
#define XB_SPIN(cond, bar) do { unsigned _sp = 0; while (cond) { __builtin_amdgcn_s_sleep(1); \
    if ((++_sp & 255u) == 0u) { if (xb_ld(&(bar)[XB_TMO])) break; if (_sp > XB_SPIN_CAP) { atomicAdd(&(bar)[XB_TMO], 1u); break; } } } } while (0)

struct XcdBarrier {
    unsigned* bar; unsigned x;
    volatile LAS unsigned* st;
};

__device__ __forceinline__ XcdBarrier xcd_barrier_post(unsigned* bar, volatile LAS unsigned* st) {
    XcdBarrier b; b.bar = bar; b.x = xb_xcc_id(); b.st = st;
    if (threadIdx.x == 0) (void)xb_add(&bar[XB_XCNT(b.x)], 1u);
    return b;
}
__device__ __forceinline__ void xcd_barrier_complete(unsigned* bar, unsigned x, unsigned& nloc, unsigned& nx) {
    const unsigned G = gridDim.x * gridDim.y * gridDim.z;
    unsigned sum, cnt, mine, sp = 0u;
    for (;;) {
        sum = 0u; cnt = 0u; mine = 0u;
#pragma unroll
        for (unsigned j = 0; j < 16; ++j) { const unsigned c = xb_ld(&bar[XB_XCNT(j)]); sum += c; cnt += (c > 0u) ? 1u : 0u; mine = (j == x) ? c : mine; }
        if (sum == G) break;
        __builtin_amdgcn_s_sleep(1);
        if ((++sp & 255u) == 0u) { if (xb_ld(&bar[XB_TMO])) break; if (sp > XB_SPIN_CAP) { atomicAdd(&bar[XB_TMO], 1u); break; } }
    }
    nloc = mine > 0u ? mine : 1u; nx = cnt > 0u ? cnt : 1u;
}

__device__ __forceinline__ void xcd_barrier(const XcdBarrier& b) {
    asm volatile("s_waitcnt vmcnt(0)" ::: "memory");
    __syncthreads();
    if (threadIdx.x == 0) {
        unsigned* bar = b.bar;
        __builtin_amdgcn_s_waitcnt(0);
        unsigned nloc = b.st[0], nx = b.st[1];
        if (nloc == 0u) { xcd_barrier_complete(bar, b.x, nloc, nx); b.st[0] = nloc; b.st[1] = nx; }
        const unsigned old = xb_add(&bar[XB_XSUB(b.x)], 1u);
        const unsigned gen = old / nloc;
        if (old + 1u == (gen + 1u) * nloc) {
            __builtin_amdgcn_fence(__ATOMIC_RELEASE, "agent");
            asm volatile("s_waitcnt vmcnt(0)" ::: "memory");
            const unsigned og = xb_add(&bar[XB_TOP], 1u);
            const unsigned tg = og / nx;
            if (og + 1u == (tg + 1u) * nx) xb_add(&bar[XB_TOPGEN], 1u);
            else XB_SPIN(xb_ld(&bar[XB_TOPGEN]) == tg, bar);
            __builtin_amdgcn_fence(__ATOMIC_ACQUIRE, "agent");
            xb_add(&bar[XB_XGEN(b.x)], 1u);
            asm volatile("s_waitcnt vmcnt(0)" ::: "memory");
        } else {
            XB_SPIN(xb_ld(&bar[XB_XGEN(b.x)]) == gen, bar);
            __builtin_amdgcn_fence(__ATOMIC_ACQUIRE, "agent");
            asm volatile("s_waitcnt vmcnt(0)" ::: "memory");
        }
    }
    __syncthreads();
}

__global__ void __launch_bounds__(512, 2) fwd_megakernel(Params p) {
    extern __shared__ __attribute__((aligned(16))) unsigned char lds_raw[];
    LAS unsigned char* lds = (LAS unsigned char*)lds_raw;
    cg::grid_group grid = cg::this_grid();
    const int wv = __builtin_amdgcn_readfirstlane((int)(threadIdx.x >> 6));
    if (threadIdx.x < 2) ((LAS unsigned*)(lds + LDS_XBST))[threadIdx.x] = 0u;
    __syncthreads();
    const XcdBarrier xbar = xcd_barrier_post((unsigned*)(p.ws + OFF_CTL + OFF_XBAR), (volatile LAS unsigned*)(lds + LDS_XBST));
    unsigned char* ws = p.ws;
    const int G = gridDim.x, bx = blockIdx.x;
    bf16_t* hb = (bf16_t*)(ws + OFF_HB) + (size_t)256 * DM;
    bf16_t* nat = (bf16_t*)(ws + OFF_NAT);
    bf16_t* act = (bf16_t*)(ws + OFF_NAT);
    bf16_t* mix = (bf16_t*)(ws + OFF_MIX);
    float* ssq = (float*)(ws + OFF_SSQ);
    float* hmeta = (float*)(ws + OFF_HMETA);
    unsigned* ctr = (unsigned*)(ws + OFF_CTL);
    LAS float* xl = (LAS float*)(lds + LDS_XCH);

    p0_prologue(p, lds, wv);
    grid.sync();
    { pg8::Gemm g{hb, (const bf16_t*)(ws + OFF_W0 + W_NAT0), DM}; pg8::Order S; S.init(NMT, NAT0 / 256, G, bx, 0);
      pg8::EpiScale E{nat, NAT0, ssq}; pg8::gemm_phase(lds, g, S, E, wv); }
    { pg8::Gemm g{(const bf16_t*)(ws + OFF_W0 + W_TR0), hb, DM}; pg8::Order S; S.init(4, NMT, G, bx, 0);
      pg8::EpiScaleT E{(bf16_t*)(ws + OFF_TR), ssq}; pg8::gemm_phase(lds, g, S, E, wv); }
    xcd_barrier(xbar);
    qknorm_phase(p, wv);
    ml_pre(p, lds, wv);
    xcd_barrier(xbar);
#ifndef NO_ML
    for (int idx = bx; idx < 128; idx += G) mlstm_scan(p, lds, G == 256 ? ((idx & 7) * 16 + (idx >> 3)) : idx, wv);
#endif
#ifndef NO_NA
    na_phase(p, lds, ctr, wv);
#endif
    xcd_barrier(xbar);
    post0_phase(p, wv);
    xcd_barrier(xbar);
    { pg8::Gemm g{mix, (const bf16_t*)(ws + OFF_W0 + W_OUT0), DM}; pg8::Order S; S.init(NMT - 1, 8, G, bx, 0);
      pg8::EpiRes E{p.in[0], hmeta, p.out, hmeta, hb, ssq + MPAD}; tail_rows(lds, g.A, g.Bt, g.K, E, wv); pg8::gemm_phase(lds, g, S, E, wv); }
    xcd_barrier(xbar);
    { pg8::Gemm g{hb, (const bf16_t*)(ws + OFF_W0 + W_UP0), DM}; pg8::Order S; S.init(130, 44, G, bx, 1);
      pg8::EpiFfn E{act, ssq + MPAD, p.in[17], p.in[18], xl};
#ifndef NO_FFN
      pg8::gemm_phase(lds, g, S, E, wv);
#endif
    }
    xcd_barrier(xbar);
    { pg8::Gemm g{act, (const bf16_t*)(ws + OFF_W0 + W_DN0), FF}; pg8::Order S; S.init(NMT - 1, 8, G, bx, 0);
      pg8::EpiRes E{p.out, hmeta, p.out, hmeta, hb, ssq + 2 * MPAD}; tail_rows(lds, g.A, g.Bt, g.K, E, wv); pg8::gemm_phase(lds, g, S, E, wv); }
    xcd_barrier(xbar);
    { pg8::Gemm g{hb, (const bf16_t*)(ws + OFF_W1 + W_NAT1), DM}; pg8::Order S; S.init(NMT, NAT1 / 256, G, bx, 0);
      pg8::EpiScale E{nat, NAT1, ssq + 2 * MPAD}; pg8::gemm_phase(lds, g, S, E, wv); }
    xcd_barrier(xbar);
#ifndef NO_GP
    gla_pre(p, lds, wv);
#endif
    xcd_barrier(xbar);
    gla_pre2(p, lds, wv);
    xcd_barrier(xbar);
#ifndef NO_GS
    for (int idx = bx; idx < 256; idx += G) gla_scan(p, lds, G == 256 ? ((idx & 7) * 32 + (idx >> 3)) : idx, wv);
#endif
    xcd_barrier(xbar);
    post1_phase(p, wv);
    xcd_barrier(xbar);
    { pg8::Gemm g{mix, (const bf16_t*)(ws + OFF_W1 + W_OUT1), DM}; pg8::Order S; S.init(NMT - 1, 8, G, bx, 0);
      pg8::EpiRes E{p.out, hmeta, p.out, hmeta, hb, ssq + 3 * MPAD}; tail_rows(lds, g.A, g.Bt, g.K, E, wv); pg8::gemm_phase(lds, g, S, E, wv); }
    xcd_barrier(xbar);
    { pg8::Gemm g{hb, (const bf16_t*)(ws + OFF_W1 + W_UP1), DM}; pg8::Order S; S.init(130, 44, G, bx, 1);
      pg8::EpiFfn E{act, ssq + 3 * MPAD, p.in[17] + 3 * FF2, p.in[18] + FF2, xl};
#ifndef NO_FFN
      pg8::gemm_phase(lds, g, S, E, wv);
#endif
    }
    xcd_barrier(xbar);
    { pg8::Gemm g{act, (const bf16_t*)(ws + OFF_W1 + W_DN1), FF}; pg8::Order S; S.init(NMT - 1, 8, G, bx, 0);
      pg8::EpiRes E{p.out, hmeta, p.out, (float*)nullptr, (bf16_t*)nullptr, (float*)nullptr}; tail_rows(lds, g.A, g.Bt, g.K, E, wv); pg8::gemm_phase(lds, g, S, E, wv); }
}

extern "C" void kernel_launch(void* const* d_in, const int* in_sizes, int n_in, void* d_out, int out_size, void* d_ws, size_t ws_size, hipStream_t stream) {
    static int grid_blocks = 0;
    if (grid_blocks == 0) {
        if (n_in != 20 || ws_size < WS_NEED) { fprintf(stderr, "kernel_launch: need 20 inputs and %zu bytes of workspace (got %d, %zu)\n", (size_t)WS_NEED, n_in, ws_size); grid_blocks = -1; return; }
        int dev = 0, cus = 0, per_cu = 0;
        hipGetDevice(&dev);
        hipDeviceGetAttribute(&cus, hipDeviceAttributeMultiprocessorCount, dev);
        if (hipFuncSetAttribute((const void*)fwd_megakernel, hipFuncAttributeMaxDynamicSharedMemorySize, LDS_BYTES) != hipSuccess) { fprintf(stderr, "kernel_launch: hipFuncSetAttribute failed\n"); }
        hipOccupancyMaxActiveBlocksPerMultiprocessor(&per_cu, (const void*)fwd_megakernel, 512, LDS_BYTES);
        if (per_cu < 1) { fprintf(stderr, "kernel_launch: occupancy query returned %d\n", per_cu); per_cu = 1; }
        (void)hipGetLastError();
        grid_blocks = cus * per_cu;
    }
    if (grid_blocks < 0) return;
    hipMemsetAsync((char*)d_ws + OFF_CTL, 0, CTL_BYTES, stream);
    Params p{};
    for (int i = 0; i < 20; ++i) p.in[i] = (const float*)d_in[i];
    p.out = (float*)d_out; p.ws = (unsigned char*)d_ws;
    void* args[] = {&p};
    hipError_t e = hipLaunchCooperativeKernel((const void*)fwd_megakernel, dim3(grid_blocks), dim3(512), args, LDS_BYTES, stream);
    if (e != hipSuccess) fprintf(stderr, "cooperative launch failed: %s (grid %d)\n", hipGetErrorString(e), grid_blocks);
}
```

```cpp
#include <hip/hip_runtime.h>
#include <hip/hip_cooperative_groups.h>
#include <cstdio>
#include <cstdint>
namespace cg = cooperative_groups;

#define LAS __attribute__((address_space(3)))
typedef unsigned short bf16_t;
typedef short bf16x8 __attribute__((ext_vector_type(8)));
typedef float f32x4 __attribute__((ext_vector_type(4)));
typedef unsigned u32x4 __attribute__((ext_vector_type(4)));
typedef unsigned u32x2 __attribute__((ext_vector_type(2)));

constexpr int NB = 2, T = 16400, SEQ = 16384, DM = 2048, M = NB * T, MPAD = 33024, NMT = 129;
constexpr int NAT0 = 5376, NAT1 = 6400, FF = 5632, FF2 = 11264;
constexpr int C_QNA = 0, C_KNA = 1024, C_QML = 2048, C_KML = 2560, C_VML = 3072, C_OML = 4096, C_GML = 5120;
constexpr int C_GQ = 0, C_GK = 1024, C_GV = 2048, C_GR = 4096, C_GLR = 6144;
constexpr float EPS = 1e-6f;
constexpr float LOG2E = 1.4426950408889634f;

constexpr size_t MiB = 1u << 20;
constexpr size_t OFF_CTL = 0, CTL_BYTES = 1 * MiB;
constexpr size_t OFF_SSQ = 64 * 1024;
constexpr size_t OFF_HMETA = 1 * MiB;
constexpr size_t OFF_ELAST = 2 * MiB;
constexpr size_t OFF_W1 = 8 * MiB;
constexpr size_t W_NAT1 = 0, W_OUT1 = (size_t)NAT1 * 4096, W_UP1 = W_OUT1 + 8 * MiB, W_DN1 = W_UP1 + 44 * MiB, W1_BYTES = W_DN1 + 22 * MiB;
constexpr size_t OFF_HB = 112 * MiB;
constexpr size_t OFF_NAT = 242 * MiB;
constexpr size_t OFF_MIX = 646 * MiB;
constexpr size_t OFF_W0 = 775 * MiB;
constexpr size_t W_NAT0 = 0, W_TR0 = 21 * MiB, W_OUT0 = 25 * MiB, W_UP0 = 33 * MiB, W_DN0 = 77 * MiB;
constexpr size_t OFF_TR = 874 * MiB;
constexpr size_t WS_NEED = 1000 * MiB;
static_assert(OFF_W1 + W1_BYTES <= OFF_HB, "map");
static_assert(OFF_HB + (size_t)(MPAD + 256) * 4096 <= OFF_NAT, "map");
static_assert(OFF_NAT + (size_t)MPAD * NAT1 * 2 <= OFF_MIX, "map");
static_assert(OFF_MIX + (size_t)MPAD * 4096 <= OFF_W0, "map");
static_assert(OFF_W0 + 99 * MiB <= OFF_TR && OFF_TR + (size_t)1024 * MPAD * 2 <= WS_NEED, "map");
static_assert(OFF_W0 + (size_t)MPAD * 4096 <= WS_NEED, "map");
static_assert((size_t)NAT0 * 4096 <= 21 * MiB, "map");

constexpr int LDS_BYTES = 147456;
constexpr int LDS_XCH = 131072;

struct Params { const float* in[20]; float* out; unsigned char* ws; };

__device__ __forceinline__ unsigned f2bf(float f) { unsigned u = __builtin_bit_cast(unsigned, f); return (u + 0x7fffu + ((u >> 16) & 1u)) >> 16; }
typedef float f32x2_pk __attribute__((ext_vector_type(2))); typedef __bf16 bf16x2_pk __attribute__((ext_vector_type(2)));
__device__ __forceinline__ unsigned pk2(float lo, float hi) { f32x2_pk v = {lo, hi}; bf16x2_pk b = __builtin_convertvector(v, bf16x2_pk); return __builtin_bit_cast(unsigned, b); }
__device__ __forceinline__ float bflo(unsigned u) { return __builtin_bit_cast(float, u << 16); }
__device__ __forceinline__ float bfhi(unsigned u) { return __builtin_bit_cast(float, u & 0xffff0000u); }
__device__ __forceinline__ float bf1(bf16_t v) { return __builtin_bit_cast(float, ((unsigned)v) << 16); }
__device__ __forceinline__ int lane_id_v() { int l; asm volatile("v_mbcnt_lo_u32_b32 %0, -1, 0\n\tv_mbcnt_hi_u32_b32 %0, -1, %0" : "=v"(l)); return l; }
__device__ __forceinline__ float sxor(float v, int m) { const int l = lane_id_v(); return __builtin_bit_cast(float, __builtin_amdgcn_ds_bpermute((l ^ m) << 2, __builtin_bit_cast(int, v))); }
__device__ __forceinline__ float sup(float v, int o) { const int l = lane_id_v(); return __builtin_bit_cast(float, __builtin_amdgcn_ds_bpermute(((l - o) & 63) << 2, __builtin_bit_cast(int, v))); }
__device__ __forceinline__ float sdown(float v, int o) { const int l = lane_id_v(); return __builtin_bit_cast(float, __builtin_amdgcn_ds_bpermute(((l + o) & 63) << 2, __builtin_bit_cast(int, v))); }
__device__ __forceinline__ float wave_sum(float v) {
#pragma unroll
    for (int o = 1; o < 64; o <<= 1) v += sxor(v, o);
    return v;
}
#define LDS_WAIT() asm volatile("s_waitcnt lgkmcnt(0)" ::: "memory")
#define BAR_LDS() do { asm volatile("s_waitcnt lgkmcnt(0)" ::: "memory"); __builtin_amdgcn_s_barrier(); asm volatile("" ::: "memory"); } while (0)
__device__ __forceinline__ int lane_id_v();
__device__ __forceinline__ int phase_tid(int wv) { return wv * 64 + lane_id_v(); }
__device__ __forceinline__ f32x4 mfma16(bf16x8 a, bf16x8 b, f32x4 c) { return __builtin_amdgcn_mfma_f32_16x16x32_bf16(a, b, c, 0, 0, 0); }
__device__ __forceinline__ float log_sigmoid(float x) { return fminf(x, 0.f) - __logf(1.0f + __expf(-fabsf(x))); }

namespace pg8 {
constexpr int BM = 256, BK = 64, HALF = 128, HTB = HALF * BK * 2, STAGE_BYTES = 8 * HTB, NXCD = 8, WGM = 4;
__host__ __device__ __forceinline__ int lds_byte(int r, int c) { const int st = (r >> 4) * 2 + (c >> 5), rr = r & 15, cc = c & 31, ob = rr * 64 + cc * 2; return st * 1024 + (ob ^ (((ob >> 9) & 1) << 5)); }
__host__ __device__ __forceinline__ void stage_rc(int b, int& R, int& C) { const int st = b / 1024, sb = b % 1024, swz = sb ^ (((sb >> 9) & 1) << 5); R = (st >> 1) * 16 + swz / 64; C = (st & 1) * 32 + (swz % 64) / 2; }
__host__ __device__ __forceinline__ int perm32(int rho) { const int n = rho >> 4, i = rho & 15; return 8 * (i >> 2) + 4 * n + (i & 3); }

struct Unit { int pm, pn; };
struct Gemm { const bf16_t* A; const bf16_t* Bt; int K; };

struct Order {
    int nM, nN, nwg, G, c, mode;
    __device__ void init(int nM_, int nN_, int G_, int c_, int mode_) { nM = nM_; nN = nN_; nwg = nM * nN; G = G_; c = c_; mode = mode_; }
    __device__ bool next(int i, Unit& u) const {
        const long L = (long)i * G + c; if (L >= nwg) return false;
        int wgid = (int)L; { const int q = nwg / NXCD, r = nwg % NXCD, xcd = wgid % NXCD, off = wgid / NXCD; wgid = (xcd < r ? xcd * (q + 1) : r * (q + 1) + (xcd - r) * q) + off; }
        const int nig = WGM * nN, gid = wgid / nig, fm = gid * WGM, gsz = (nM - fm) < WGM ? (nM - fm) : WGM;
        u.pm = fm + ((wgid % nig) % gsz); u.pn = (wgid % nig) / gsz; return true;
    }
    __device__ __forceinline__ long arow(const Unit& u) const { return mode ? (long)(u.pm / 65) * T + (long)(u.pm % 65) * 254 - 1 : (long)u.pm * 256; }
};

typedef float f32x2_t __attribute__((ext_vector_type(2))); typedef __bf16 bf16x2_t __attribute__((ext_vector_type(2)));
__device__ __forceinline__ unsigned cvt_pk_bf16(float lo, float hi) { f32x2_t v = {lo, hi}; bf16x2_t b = __builtin_convertvector(v, bf16x2_t); return __builtin_bit_cast(unsigned, b); }

struct EpiScale {
    static constexpr bool PERM = true;
    bf16_t* O; int ldc; const float* ssq;
    __device__ __forceinline__ void operator()(f32x4 (&acc)[2][2][4][2], const Unit& u, int wr, int wc, int fr, int fq) const {
#pragma unroll
        for (int ai = 0; ai < 2; ++ai)
#pragma unroll
            for (int m = 0; m < 4; ++m) {
                const int g = u.pm * BM + ai * HALF + wr * 64 + m * 16 + fr; const bool ok = g < M;
                const float rs = ok ? rsqrtf(ssq[g] * (1.0f / DM) + EPS) : 0.f;
                bf16_t* rowp = O + (size_t)g * ldc + u.pn * BM + wc * 32 + 8 * fq;
#pragma unroll
                for (int bj = 0; bj < 2; ++bj) {
                    f32x4 v0 = acc[ai][bj][m][0], v1 = acc[ai][bj][m][1]; u32x4 w;
                    if (ok) { w.x = cvt_pk_bf16(v0[0] * rs, v0[1] * rs); w.y = cvt_pk_bf16(v0[2] * rs, v0[3] * rs); w.z = cvt_pk_bf16(v1[0] * rs, v1[1] * rs); w.w = cvt_pk_bf16(v1[2] * rs, v1[3] * rs); }
                    else { w = (u32x4){0u, 0u, 0u, 0u}; }
                    *(u32x4*)(rowp + bj * HALF) = w;
                }
            }
    }
};
struct EpiScaleT {
    static constexpr bool PERM = true;
    bf16_t* O; const float* ssq;
    __device__ __forceinline__ void operator()(f32x4 (&acc)[2][2][4][2], const Unit& u, int wr, int wc, int fr, int fq) const {
        f32x4 rs[2][2];
#pragma unroll
        for (int bj = 0; bj < 2; ++bj)
#pragma unroll
            for (int n = 0; n < 2; ++n) { const int tk = u.pn * BM + bj * HALF + wc * 32 + 8 * fq + 4 * n;
#pragma unroll
                for (int e = 0; e < 4; ++e) rs[bj][n][e] = (tk + e) < M ? rsqrtf(ssq[tk + e] * (1.0f / DM) + EPS) : 0.f; }
#pragma unroll
        for (int ai = 0; ai < 2; ++ai)
#pragma unroll
            for (int m = 0; m < 4; ++m) {
                const int g = u.pm * BM + ai * HALF + wr * 64 + m * 16 + fr;
                bf16_t* rowp = O + (size_t)g * MPAD + u.pn * BM + wc * 32 + 8 * fq;
#pragma unroll
                for (int bj = 0; bj < 2; ++bj) {
                    f32x4 v0 = acc[ai][bj][m][0], v1 = acc[ai][bj][m][1]; u32x4 w;
#pragma unroll
                    for (int e = 0; e < 4; ++e) { v0[e] = rs[bj][0][e] != 0.f ? v0[e] * rs[bj][0][e] : 0.f; v1[e] = rs[bj][1][e] != 0.f ? v1[e] * rs[bj][1][e] : 0.f; }
                    w.x = cvt_pk_bf16(v0[0], v0[1]); w.y = cvt_pk_bf16(v0[2], v0[3]); w.z = cvt_pk_bf16(v1[0], v1[1]); w.w = cvt_pk_bf16(v1[2], v1[3]);
                    *(u32x4*)(rowp + bj * HALF) = w;
                }
            }
    }
};
struct EpiRes {
    static constexpr bool PERM = true;
    const float* srcx; const float* srcm; float* dstx; float* dstm; bf16_t* hb; float* ssq;
    __device__ __forceinline__ void operator()(f32x4 (&acc)[2][2][4][2], const Unit& u, int wr, int wc, int fr, int fq) const {
#pragma unroll
        for (int ai = 0; ai < 2; ++ai)
#pragma unroll
            for (int m = 0; m < 4; ++m) {
                const int g = u.pm * BM + ai * HALF + wr * 64 + m * 16 + fr; float ss = 0.f;
                if (g < M) {
                    const int b = g >= T ? 1 : 0, t = g - b * T;
                    const float* sp = t < 16 ? srcm + (size_t)(b * 16 + t) * DM : srcx + ((size_t)b * SEQ + (t - 16)) * DM;
                    float* dp = t < 16 ? (dstm ? dstm + (size_t)(b * 16 + t) * DM : (float*)nullptr) : dstx + ((size_t)b * SEQ + (t - 16)) * DM;
                    const int col0 = u.pn * BM + wc * 32 + 8 * fq;
#pragma unroll
                    for (int bj = 0; bj < 2; ++bj) {
                        const int col = col0 + bj * HALF;
                        const f32x4 v0 = *(const f32x4*)(sp + col) + acc[ai][bj][m][0], v1 = *(const f32x4*)(sp + col + 4) + acc[ai][bj][m][1];
                        if (dp) { *(f32x4*)(dp + col) = v0; *(f32x4*)(dp + col + 4) = v1; }
                        if (hb) { u32x4 w; w.x = cvt_pk_bf16(v0[0], v0[1]); w.y = cvt_pk_bf16(v0[2], v0[3]); w.z = cvt_pk_bf16(v1[0], v1[1]); w.w = cvt_pk_bf16(v1[2], v1[3]); *(u32x4*)(hb + (size_t)g * DM + col) = w; }
                        ss += (v0[0] * v0[0] + v0[1] * v0[1]) + (v0[2] * v0[2] + v0[3] * v0[3]) + (v1[0] * v1[0] + v1[1] * v1[1]) + (v1[2] * v1[2] + v1[3] * v1[3]);
                    }
                }
                ss += sxor(ss, 16); ss += sxor(ss, 32);
                if (ssq && fq == 0 && g < M) atomicAdd(ssq + g, ss);
            }
    }
};
__device__ __forceinline__ float dppf(float old, float src, const int ctrl_sel) {
    int r;
    if (ctrl_sel == 0) r = __builtin_amdgcn_mov_dpp(__builtin_bit_cast(int, src), 0x121, 0xf, 0xf, true);
    else if (ctrl_sel == 1) r = __builtin_amdgcn_update_dpp(__builtin_bit_cast(int, old), __builtin_bit_cast(int, src), 0x111, 0xf, 0xf, false);
    else if (ctrl_sel == 2) r = __builtin_amdgcn_mov_dpp(__builtin_bit_cast(int, src), 0x12f, 0xf, 0xf, true);
    else r = __builtin_amdgcn_update_dpp(__builtin_bit_cast(int, old), __builtin_bit_cast(int, src), 0x101, 0xf, 0xf, false);
    return __builtin_bit_cast(float, r);
}
struct EpiFfn {
    static constexpr bool PERM = true;
    bf16_t* act; const float* ssq; const float* cw; const float* cb; LAS float* xl;
    __device__ __forceinline__ void operator()(f32x4 (&acc)[2][2][4][2], const Unit& u, int wr, int wc, int fr_in, int fq_in) const {
        int lane_e; asm volatile("v_mbcnt_lo_u32_b32 %0, -1, 0\n\tv_mbcnt_hi_u32_b32 %0, -1, %0" : "=v"(lane_e));
        int fr = lane_e & 15, fq = lane_e >> 4; (void)fr_in; (void)fq_in;
        const int b = u.pm / 65, jt = u.pm % 65, tb = jt * 254 - 1;
#pragma unroll
        for (int ai = 0; ai < 2; ++ai)
#pragma unroll
            for (int m = 0; m < 4; ++m) {
                const int t = tb + ai * HALF + wr * 64 + m * 16 + fr; const bool ok = (t >= 0) && (t < T);
                const float rs = ok ? rsqrtf(ssq[b * T + (ok ? t : 0)] * (1.0f / DM) + EPS) : 0.f;
#pragma unroll
                for (int bj = 0; bj < 2; ++bj)
#pragma unroll
                    for (int n = 0; n < 2; ++n)
#pragma unroll
                        for (int e = 0; e < 4; ++e) acc[ai][bj][m][n][e] = acc[ai][bj][m][n][e] * rs;
            }
        asm volatile("" : "+v"(fr), "+v"(fq));
#pragma unroll
        for (int ai = 0; ai < 2; ++ai) { const int blk = 2 * ai + wr;
#pragma unroll
            for (int bj = 0; bj < 2; ++bj)
#pragma unroll
                for (int n = 0; n < 2; ++n) {
                    if (fr == 0)  *(LAS f32x4*)(xl + ((((blk * 2 + 0) * 4 + wc) * 2 + bj) * 32 + 8 * fq + 4 * n)) = acc[ai][bj][0][n];
                    if (fr == 15) *(LAS f32x4*)(xl + ((((blk * 2 + 1) * 4 + wc) * 2 + bj) * 32 + 8 * fq + 4 * n)) = acc[ai][bj][3][n];
                } }
        LAS float* pl = xl + 2048;
        { const int tix = (wr * 4 + wc) * 64 + (fq * 16 + fr);
#pragma unroll
          for (int i = 0; i < 2; ++i) { const int id = tix + 512 * i, k = id >> 8, tc = id & 255; const int ch = (tc < 128 ? 0 : FF) + u.pn * HALF + (tc & 127);
              pl[id] = k < 3 ? cw[k * FF2 + ch] : cb[ch]; } }
        LDS_WAIT(); __builtin_amdgcn_s_barrier(); asm volatile("" ::: "memory");
        asm volatile("" : "+v"(fr), "+v"(fq));
        LAS float* pb = pl + wc * 32 + 8 * fq; asm volatile("" : "+v"(pb));
        LAS float* xb = xl + 512 + wr * 512 + wc * 64 + 8 * fq - 512 - 512; asm volatile("" : "+v"(xb));
#pragma unroll
        for (int ai = 0; ai < 2; ++ai) { const int blk = 2 * ai + wr;
#pragma unroll
            for (int m = 0; m < 4; ++m) {
                const int r = ai * HALF + wr * 64 + m * 16 + fr, t = tb + r;
                float o[8];
#pragma unroll
                for (int n = 0; n < 2; ++n) {
                    f32x4 y[2];
#pragma unroll
                    for (int bj = 0; bj < 2; ++bj) {
                        const int pc = bj * 128 + 4 * n;
                        const f32x4 w0 = *(LAS const f32x4*)(pb + pc), w1 = *(LAS const f32x4*)(pb + 256 + pc), w2 = *(LAS const f32x4*)(pb + 512 + pc), bb = *(LAS const f32x4*)(pb + 768 + pc);
                        f32x4 ps, ns;
                        if (m > 0) ps = acc[ai][bj][m > 0 ? m - 1 : 0][n];
                        else ps = blk > 0 ? *(LAS const f32x4*)(xb + (ai * 1024 + 256 + bj * 32 + 4 * n)) : (f32x4){0.f, 0.f, 0.f, 0.f};
                        if (m < 3) ns = acc[ai][bj][m < 3 ? m + 1 : 3][n];
                        else ns = blk < 3 ? *(LAS const f32x4*)(xb + (ai * 1024 + 1024 + bj * 32 + 4 * n)) : (f32x4){0.f, 0.f, 0.f, 0.f};
                        const f32x4 cur = acc[ai][bj][m][n];
#pragma unroll
                        for (int e = 0; e < 4; ++e) {
                            const float t1 = m > 0 ? dppf(0.f, ps[e], 0) : ps[e];
                            const float pv = dppf(t1, cur[e], 1);
                            const float t2 = m < 3 ? dppf(0.f, ns[e], 2) : ns[e];
                            const float nx = dppf(t2, cur[e], 3);
                            y[bj][e] = bb[e] + w0[e] * pv + w1[e] * cur[e] + w2[e] * nx;
                        }
                        __builtin_amdgcn_sched_barrier(0);
                    }
#pragma unroll
                    for (int e = 0; e < 4; ++e) { const float g = y[0][e]; o[4 * n + e] = g * y[1][e] * __builtin_amdgcn_rcpf(1.0f + __expf(-g)); }
                }
                if (r >= 1 && r < 255 && t < T) {
                    u32x4 w; w.x = cvt_pk_bf16(o[0], o[1]); w.y = cvt_pk_bf16(o[2], o[3]); w.z = cvt_pk_bf16(o[4], o[5]); w.w = cvt_pk_bf16(o[6], o[7]);
                    *(u32x4*)(act + (size_t)(b * T + t) * FF + u.pn * HALF + wc * 32 + 8 * fq) = w;
                }
                __builtin_amdgcn_sched_barrier(0);
            }
        }
    }
};

template <class Epi>
__device__ __forceinline__ void gemm_phase(LAS unsigned char* lds, const Gemm g, const Order& S, const Epi& E, int wv) {
    const int tid = phase_tid(wv), wid = __builtin_amdgcn_readfirstlane(tid >> 6), lane = tid & 63, wr = wid >> 2, wc = wid & 3, fr = lane & 15, fq = lane >> 4;
    const int K = g.K, nt = K / BK;
    unsigned voffA[2], voffB[2];
#pragma unroll
    for (int i = 0; i < 2; ++i) { int R, C; stage_rc(tid * 16 + i * 8192, R, C); const int Rb = Epi::PERM ? ((R & ~31) + perm32(R & 31)) : R;
        voffA[i] = (unsigned)(R * K + C) * 2u; voffB[i] = (unsigned)(Rb * K + C) * 2u; }
    const size_t kstep = (size_t)(BK * 2);
    const size_t hstep = (size_t)HALF * K * 2;
    const size_t tstep = 2 * hstep;
    const long rowb = (long)K * 2;
    const unsigned ldsw = (unsigned)wid * 1024u;
    const int aoff = lds_byte(wr * 64 + fr, fq * 8), boff = lds_byte(wc * 32 + fr, fq * 8);
#define PG8_SA(b, h) (((b) * 2 + (h)) * HTB)
#define PG8_SB(b, h) ((4 + (b) * 2 + (h)) * HTB)
#define PG8_STAGE(bufoff, gbase, voff) do { _Pragma("unroll") for (int _i = 0; _i < 2; ++_i) \
        __builtin_amdgcn_global_load_lds((const unsigned*)((const char*)(gbase) + (voff)[_i]), (LAS unsigned*)(lds + (bufoff) + ldsw + _i * 8192), 16, 0, 0); } while (0)
#define PG8_LDA(dst, b, h) do { _Pragma("unroll") for (int m = 0; m < 4; ++m) _Pragma("unroll") for (int k = 0; k < 2; ++k) dst[m][k] = *(const LAS bf16x8*)(lds + PG8_SA(b, h) + aoff + m * 2048 + k * 1024); } while (0)
#define PG8_LDB(dst, b, h) do { _Pragma("unroll") for (int n = 0; n < 2; ++n) _Pragma("unroll") for (int k = 0; k < 2; ++k) dst[n][k] = *(const LAS bf16x8*)(lds + PG8_SB(b, h) + boff + n * 2048 + k * 1024); } while (0)
#define PG8_MMA(ai, bj, At, Bt) do { __builtin_amdgcn_s_setprio(1); _Pragma("unroll") for (int m = 0; m < 4; ++m) _Pragma("unroll") for (int n = 0; n < 2; ++n) _Pragma("unroll") for (int k = 0; k < 2; ++k) \
        acc[ai][bj][m][n] = __builtin_amdgcn_mfma_f32_16x16x32_bf16(Bt[n][k], At[m][k], acc[ai][bj][m][n], 0, 0, 0); __builtin_amdgcn_s_setprio(0); } while (0)
#define PG8_WAIT_V(n) asm volatile("s_waitcnt vmcnt(" #n ")" ::: "memory")
#define PG8_WAIT_L(n) asm volatile("s_waitcnt lgkmcnt(" #n ")" ::: "memory")
#define PG8_BAR __builtin_amdgcn_s_barrier()
#define PG8_SCHED __builtin_amdgcn_sched_barrier(0)
    Unit cur, nxt; int ui = 0;
    if (!S.next(0, cur)) return;
    f32x4 acc[2][2][4][2];
#pragma unroll
    for (int a = 0; a < 2; ++a)
#pragma unroll
        for (int b = 0; b < 2; ++b)
#pragma unroll
            for (int m = 0; m < 4; ++m)
#pragma unroll
                for (int n = 0; n < 2; ++n) acc[a][b][m][n] = (f32x4){0.f, 0.f, 0.f, 0.f};
    bf16x8 At[4][2], B0[2][2], B1[2][2];
    const char* cA = (const char*)g.A + S.arow(cur) * rowb; const char* cB = (const char*)g.Bt + (size_t)cur.pn * tstep;
    PG8_STAGE(PG8_SB(0, 0), cB, voffB); PG8_STAGE(PG8_SB(0, 1), cB + hstep, voffB); PG8_STAGE(PG8_SA(0, 0), cA, voffA); PG8_STAGE(PG8_SA(0, 1), cA + hstep, voffA);
    if (wr == 1) PG8_BAR;
    PG8_WAIT_V(2); PG8_BAR;
    PG8_STAGE(PG8_SB(1, 0), cB + kstep, voffB); PG8_STAGE(PG8_SA(1, 0), cA + kstep, voffA); PG8_STAGE(PG8_SB(1, 1), cB + hstep + kstep, voffB);
    PG8_WAIT_V(6); PG8_BAR;
    for (;;) {
        const bool has_next = S.next(ui + 1, nxt);
        const char* nA = has_next ? (const char*)g.A + S.arow(nxt) * rowb : cA; const char* nB = has_next ? (const char*)g.Bt + (size_t)nxt.pn * tstep : cB;
        for (int t = 0; t < nt; t += 2) {
            const bool last = (t == nt - 2);
            const char* a1 = cA + (size_t)(t + 1) * kstep;
            const char* a2 = last ? nA : cA + (size_t)(t + 2) * kstep; const char* b2 = last ? nB : cB + (size_t)(t + 2) * kstep;
            const char* a3 = a2 + kstep; const char* b3 = b2 + kstep;
            PG8_LDB(B0, 0, 0); PG8_LDB(B1, 0, 1); PG8_SCHED; PG8_LDA(At, 0, 0); PG8_STAGE(PG8_SA(1, 1), a1 + hstep, voffA);
            PG8_WAIT_V(8); PG8_WAIT_L(0); PG8_BAR; PG8_MMA(0, 0, At, B0); PG8_MMA(0, 1, At, B1); PG8_BAR; PG8_SCHED;
            PG8_LDA(At, 0, 1); PG8_STAGE(PG8_SB(0, 0), b2, voffB); PG8_STAGE(PG8_SB(0, 1), b2 + hstep, voffB); PG8_STAGE(PG8_SA(0, 0), a2, voffA);
            PG8_WAIT_V(8); PG8_WAIT_L(0); PG8_BAR; PG8_MMA(1, 0, At, B0); PG8_MMA(1, 1, At, B1); PG8_BAR; PG8_SCHED;
            PG8_LDB(B0, 1, 0); PG8_LDB(B1, 1, 1); PG8_SCHED; PG8_LDA(At, 1, 0); PG8_STAGE(PG8_SA(0, 1), a2 + hstep, voffA);
            PG8_WAIT_V(8); PG8_WAIT_L(0); PG8_BAR; PG8_MMA(0, 0, At, B0); PG8_MMA(0, 1, At, B1); PG8_BAR; PG8_SCHED;
            PG8_LDA(At, 1, 1); PG8_STAGE(PG8_SB(1, 0), b3, voffB); PG8_STAGE(PG8_SB(1, 1), b3 + hstep, voffB); PG8_STAGE(PG8_SA(1, 0), a3, voffA);
            PG8_WAIT_V(8); PG8_WAIT_L(0); PG8_BAR; PG8_MMA(1, 0, At, B0); PG8_MMA(1, 1, At, B1); PG8_BAR; PG8_SCHED;
        }
        if (wr == 0) PG8_BAR;
        E(acc, cur, wr, wc, fr, fq);
        if (!has_next) break;
#pragma unroll
        for (int a = 0; a < 2; ++a)
#pragma unroll
            for (int b = 0; b < 2; ++b)
#pragma unroll
                for (int m = 0; m < 4; ++m)
#pragma unroll
                    for (int n = 0; n < 2; ++n) acc[a][b][m][n] = (f32x4){0.f, 0.f, 0.f, 0.f};
        cur = nxt; cA = nA; cB = nB; ++ui;
        if (wr == 1) PG8_BAR;
    }
    PG8_WAIT_V(0);
    PG8_BAR;
#undef PG8_SA
#undef PG8_SB
#undef PG8_STAGE
#undef PG8_LDA
#undef PG8_LDB
#undef PG8_MMA
#undef PG8_WAIT_V
#undef PG8_WAIT_L
#undef PG8_BAR
#undef PG8_SCHED
}
}

struct Job { const float* W; int K, ldw, c0, nc; bf16_t* dst; int ldd; const float* gain; float cs; int mode; };
__device__ __forceinline__ int ffnrow(int c) { return c < FF ? 256 * (c >> 7) + (c & 127) : 256 * ((c - FF) >> 7) + 128 + ((c - FF) & 127); }
__device__ __forceinline__ void conv_item(const Job& J, int item, LAS float* scr, int lane) {
    const int nblk = (J.nc + 63) >> 6, kb = item / nblk, nb = item % nblk, k0 = 64 * kb, n0 = 64 * nb;
    const int c4 = 4 * (lane & 15), kr = lane >> 4; const bool cv = (n0 + c4) < J.nc;
#pragma unroll
    for (int hb_ = 0; hb_ < 2; ++hb_) {
        f32x4 v[8];
#pragma unroll
        for (int i = 0; i < 8; ++i) { const int kk = 32 * hb_ + 4 * i + kr;
            v[i] = cv ? *(const f32x4*)(J.W + (size_t)(k0 + kk) * J.ldw + J.c0 + n0 + c4) : (f32x4){0.f, 0.f, 0.f, 0.f}; }
#pragma unroll
        for (int i = 0; i < 8; ++i) { const int kk = 32 * hb_ + 4 * i + kr; const float gm = (J.gain ? J.gain[k0 + kk] : 1.0f) * J.cs;
            LAS float* s = scr + kk * 65 + c4; s[0] = v[i][0] * gm; s[1] = v[i][1] * gm; s[2] = v[i][2] * gm; s[3] = v[i][3] * gm; }
    }
    LDS_WAIT(); asm volatile("" ::: "memory");
    const int c = lane & 7;
#pragma unroll
    for (int j = 0; j < 8; ++j) { const int n = (lane >> 3) + 8 * j; const LAS float* s = scr + (8 * c) * 65 + n;
        u32x4 o; o.x = pk2(s[0 * 65], s[1 * 65]); o.y = pk2(s[2 * 65], s[3 * 65]); o.z = pk2(s[4 * 65], s[5 * 65]); o.w = pk2(s[6 * 65], s[7 * 65]);
        if (n0 + n < J.nc) { const int drow = J.mode ? ffnrow(J.c0 + n0 + n) : (n0 + n);
            *(u32x4*)(J.dst + (size_t)drow * J.ldd + k0 + 8 * c) = o; } }
    LDS_WAIT(); asm volatile("" ::: "memory");
}
__device__ __forceinline__ Job get_job(const Params& p, int j) {
    unsigned char* ws = p.ws;
    bf16_t* natw0 = (bf16_t*)(ws + OFF_W0 + W_NAT0); bf16_t* trw0 = (bf16_t*)(ws + OFF_W0 + W_TR0);
    bf16_t* natw1 = (bf16_t*)(ws + OFF_W1 + W_NAT1);
    Job J; J.gain = nullptr; J.cs = 1.f; J.mode = 0; J.K = DM; J.ldd = DM;
    switch (j) {
    case 0: J.W = p.in[4]; J.ldw = 6160; J.c0 = 0; J.nc = 2048; J.dst = natw0; J.gain = p.in[2]; break;
    case 1: J.W = p.in[4]; J.ldw = 6160; J.c0 = 2048; J.nc = 1024; J.dst = trw0; J.gain = p.in[2]; break;
    case 2: J.W = p.in[4]; J.ldw = 6160; J.c0 = 3072; J.nc = 512; J.dst = natw0 + (size_t)C_QML * DM; J.gain = p.in[2]; break;
    case 3: J.W = p.in[4]; J.ldw = 6160; J.c0 = 3584; J.nc = 512; J.dst = natw0 + (size_t)C_KML * DM; J.gain = p.in[2]; J.cs = 0.08838834764831845f; break;
    case 4: J.W = p.in[4]; J.ldw = 6160; J.c0 = 4096; J.nc = 2048; J.dst = natw0 + (size_t)C_VML * DM; J.gain = p.in[2]; break;
    case 5: J.W = p.in[4]; J.ldw = 6160; J.c0 = 6144; J.nc = 16; J.dst = natw0 + (size_t)C_GML * DM; J.gain = p.in[2]; break;
    case 6: J.W = p.in[10]; J.ldw = 2048; J.c0 = 0; J.nc = 2048; J.dst = (bf16_t*)(ws + OFF_W0 + W_OUT0); break;
    case 7: J.W = p.in[16]; J.ldw = FF2; J.c0 = 0; J.nc = FF2; J.dst = (bf16_t*)(ws + OFF_W0 + W_UP0); J.gain = p.in[3]; J.mode = 1; break;
    case 8: J.W = p.in[19]; J.K = FF; J.ldw = 2048; J.c0 = 0; J.nc = 2048; J.dst = (bf16_t*)(ws + OFF_W0 + W_DN0); J.ldd = FF; break;
    case 9: J.W = p.in[11]; J.ldw = 6176; J.c0 = 0; J.nc = 1024; J.dst = natw1; J.gain = p.in[2] + DM; J.cs = 0.0625f; break;
    case 10: J.W = p.in[11]; J.ldw = 6176; J.c0 = 1024; J.nc = 5120; J.dst = natw1 + (size_t)1024 * DM; J.gain = p.in[2] + DM; break;
    case 11: J.W = p.in[11]; J.ldw = 6176; J.c0 = 6144; J.nc = 32; J.dst = natw1 + (size_t)C_GLR * DM; J.gain = p.in[2] + DM; break;
    case 12: J.W = p.in[15]; J.ldw = 2048; J.c0 = 0; J.nc = 2048; J.dst = (bf16_t*)(ws + OFF_W1 + W_OUT1); break;
    case 13: J.W = p.in[16] + (size_t)DM * FF2; J.ldw = FF2; J.c0 = 0; J.nc = FF2; J.dst = (bf16_t*)(ws + OFF_W1 + W_UP1); J.gain = p.in[3] + DM; J.mode = 1; break;
    default: J.W = p.in[19] + (size_t)FF * DM; J.K = FF; J.ldw = 2048; J.c0 = 0; J.nc = 2048; J.dst = (bf16_t*)(ws + OFF_W1 + W_DN1); J.ldd = FF; break;
    }
    return J;
}
constexpr int NJOBS = 15;

__device__ __forceinline__ void p0_prologue(const Params& p, LAS unsigned char* lds, int wv) {
    const int tid = phase_tid(wv), lane = tid & 63, wave = tid >> 6;
    const int gw = blockIdx.x * 8 + wave, NGW = gridDim.x * 8;
    unsigned char* ws = p.ws;
    bf16_t* hb = (bf16_t*)(ws + OFF_HB) + (size_t)256 * DM;
    float* ssq0 = (float*)(ws + OFF_SSQ);
    float* hmeta = (float*)(ws + OFF_HMETA);
    for (int g = gw; g < M; g += NGW) {
        const int b = g >= T ? 1 : 0, t = g - b * T;
        const float* src = t < 16 ? p.in[1] + (size_t)t * DM : p.in[0] + ((size_t)b * SEQ + (t - 16)) * DM;
        float s = 0.f;
#pragma unroll
        for (int j = 0; j < 8; ++j) { const f32x4 v = *(const f32x4*)(src + 4 * lane + 256 * j);
            s += (v[0] * v[0] + v[1] * v[1]) + (v[2] * v[2] + v[3] * v[3]);
            u32x2 w; w.x = pk2(v[0], v[1]); w.y = pk2(v[2], v[3]); *(u32x2*)(hb + (size_t)g * DM + 4 * lane + 256 * j) = w;
            if (t < 16) *(f32x4*)(hmeta + (size_t)(b * 16 + t) * DM + 4 * lane + 256 * j) = v; }
        s = wave_sum(s);
        if (lane == 0) ssq0[g] = s;
    }
    for (int r = gw; r < 256 + (MPAD - M); r += NGW) { const long row = r < 256 ? (long)r - 256 : (long)M + (r - 256);
#pragma unroll
        for (int j = 0; j < 4; ++j) *(u32x4*)(hb + row * DM + 8 * lane + 512 * j) = (u32x4){0u, 0u, 0u, 0u}; }
    { bf16_t* natw0 = (bf16_t*)(ws + OFF_W0 + W_NAT0); bf16_t* natw1 = (bf16_t*)(ws + OFF_W1 + W_NAT1);
      const int z0 = NAT0 - 5136, z1 = NAT1 - 6176;
      for (int r = gw; r < z0 + z1; r += NGW) { bf16_t* rowp = r < z0 ? natw0 + (size_t)(5136 + r) * DM : natw1 + (size_t)(6176 + (r - z0)) * DM;
#pragma unroll
          for (int j = 0; j < 4; ++j) *(u32x4*)(rowp + 8 * lane + 512 * j) = (u32x4){0u, 0u, 0u, 0u}; } }
    LAS float* scr = (LAS float*)(lds + wave * 16640);
    for (int j = 0; j < NJOBS; ++j) {
        const Job J = get_job(p, j);
        const int nitems = (J.K / 64) * ((J.nc + 63) >> 6);
        for (int it = gw; it < nitems; it += NGW) conv_item(J, it, scr, lane);
    }
}

__device__ __forceinline__ void qknorm_phase(const Params& p, int wv) {
    const int tid = phase_tid(wv), lane = tid & 63, wave = tid >> 6;
    const int gw = blockIdx.x * 8 + wave, NGW = gridDim.x * 8;
    bf16_t* nat = (bf16_t*)(p.ws + OFF_NAT);
    const float qs = 0.08838834764831845f * LOG2E;
    for (int g = gw; g < M; g += NGW) {
#pragma unroll
        for (int j = 0; j < 4; ++j) {
            const int col = 8 * lane + 512 * j;
            u32x4 v = *(const u32x4*)(nat + (size_t)g * NAT0 + col);
            float f[8] = {bflo(v.x), bfhi(v.x), bflo(v.y), bfhi(v.y), bflo(v.z), bfhi(v.z), bflo(v.w), bfhi(v.w)};
            float s = 0.f;
#pragma unroll
            for (int e = 0; e < 8; ++e) s += f[e] * f[e];
            s += sxor(s, 1); s += sxor(s, 2); s += sxor(s, 4); s += sxor(s, 8);
            const float rs = rsqrtf(s * (1.0f / 128.0f) + EPS);
            const bool isq = col < 1024; const float* gn = (isq ? p.in[6] : p.in[7]) + (col & 127);
            const float sc = isq ? rs * qs : rs;
#pragma unroll
            for (int e = 0; e < 8; ++e) f[e] = f[e] * sc * gn[e];
            v.x = pk2(f[0], f[1]); v.y = pk2(f[2], f[3]); v.z = pk2(f[4], f[5]); v.w = pk2(f[6], f[7]);
            *(u32x4*)(nat + (size_t)g * NAT0 + col) = v;
        }
    }
}

constexpr int NA_UNITS = NB * 256 * 4 * 8 + NB * 8;
#define NA_KLOAD(DST_, I_) do { const int tb_ = (I_) < 8 ? b * T + 16 + (r0 + (I_)) * 64 + cs : b * T; \
        _Pragma("unroll") for (int tau = 0; tau < 2; ++tau) { const bf16_t* kp_ = kbase + (size_t)(tb_ + 8 * (jq >> 2) + 4 * tau + (jq & 3)) * NAT0; \
            _Pragma("unroll") for (int kk = 0; kk < 4; ++kk) DST_[tau * 4 + kk] = *(const bf16x8*)(kp_ + 32 * kk); } } while (0)
#define NA_SCORE(SRC_, I_) do { \
        _Pragma("unroll") for (int tau = 0; tau < 2; ++tau) { f32x4 a_ = (f32x4){0.f, 0.f, 0.f, 0.f}; \
            _Pragma("unroll") for (int kk = 0; kk < 4; ++kk) a_ = mfma16(SRC_[tau * 4 + kk], qf[kk], a_); \
            _Pragma("unroll") for (int rho = 0; rho < 4; ++rho) { float s_; \
                if ((I_) < 8) { const int kc = cs + 8 * q + 4 * tau + rho; const bool ok = (kc >= c0) && (kc < c0 + 16); \
                    int dc = kc - qc + 15; dc = dc < 0 ? 0 : (dc > 30 ? 30 : dc); const int dr = r0 - r + (I_) + 7; \
                    s_ = ok ? a_[rho] + rb[dr * 31 + dc] : -INFINITY; } \
                else { s_ = (q < 2) ? a_[rho] : -INFINITY; } \
                a_[rho] = s_; mx = fmaxf(mx, s_); } \
            sc[I_][tau] = a_; } } while (0)
#define NA_VLOAD(DST_, I_) do { const int tb_ = (I_) < 8 ? b * T + 16 + (r0 + (I_)) * 64 + cs : b * T; \
        const bf16_t* vp_ = vt + (size_t)(h * 128 + jq) * MPAD + tb_ + 8 * q; \
        _Pragma("unroll") for (int dt = 0; dt < 8; ++dt) DST_[dt] = *(const bf16x8*)(vp_ + (size_t)(16 * dt) * MPAD); } while (0)
#define NA_PV(SRC_, I_) do { float pv_[8]; \
        _Pragma("unroll") for (int tau = 0; tau < 2; ++tau) \
            _Pragma("unroll") for (int rho = 0; rho < 4; ++rho) { const float e_ = __builtin_amdgcn_exp2f(sc[I_][tau][rho] - mx); pv_[4 * tau + rho] = e_; sum += e_; } \
        u32x4 pw_; pw_.x = pk2(pv_[0], pv_[1]); pw_.y = pk2(pv_[2], pv_[3]); pw_.z = pk2(pv_[4], pv_[5]); pw_.w = pk2(pv_[6], pv_[7]); \
        const bf16x8 pf_ = __builtin_bit_cast(bf16x8, pw_); \
        _Pragma("unroll") for (int dt = 0; dt < 8; ++dt) o[dt] = mfma16(SRC_[dt], pf_, o[dt]); } while (0)
__device__ __forceinline__ void na_unit(const Params& p, int id, int lane, const LAS float* rbt) {
    const bf16_t* nat = (const bf16_t*)(p.ws + OFF_NAT);
    const bf16_t* vt = (const bf16_t*)(p.ws + OFF_TR);
    bf16_t* mix = (bf16_t*)(p.ws + OFF_MIX);
    const int jq = lane & 15, q = lane >> 4;
    int b, h, r = 0, j = 0, r0 = 0, cs = 0, qtok; bool meta;
    if (id < NB * 256 * 4 * 8) { h = id & 7; j = (id >> 3) & 3; r = (id >> 5) & 255; b = id >> 13;
        r0 = r - 4; r0 = r0 < 0 ? 0 : (r0 > 248 ? 248 : r0); cs = 16 * j - 8; cs = cs < 0 ? 0 : (cs > 32 ? 32 : cs);
        qtok = b * T + 16 + r * 64 + 16 * j; meta = false; }
    else { const int m = id - NB * 256 * 4 * 8; h = m & 7; b = m >> 3; qtok = b * T; meta = true; }
    bf16x8 qf[4];
    { const bf16_t* qp = nat + (size_t)(qtok + jq) * NAT0 + C_QNA + h * 128 + 8 * q;
#pragma unroll
      for (int kk = 0; kk < 4; ++kk) qf[kk] = *(const bf16x8*)(qp + 32 * kk); }
    f32x4 sc[9][2];
    const bf16_t* kbase = nat + C_KNA + h * 128 + 8 * q;
    const LAS float* rb = rbt + h * (15 * 31);
    const int qc = 16 * j + jq; int c0 = qc - 8; c0 = c0 < 0 ? 0 : (c0 > 48 ? 48 : c0);
    float mx = -INFINITY, sum = 0.f;
    f32x4 o[8];
#pragma unroll
    for (int dt = 0; dt < 8; ++dt) o[dt] = (f32x4){0.f, 0.f, 0.f, 0.f};
    bf16x8 fa[8], fb[8];
    if (!meta) {
        NA_KLOAD(fa, 0);
        NA_KLOAD(fb, 1); NA_SCORE(fa, 0);
        NA_KLOAD(fa, 2); NA_SCORE(fb, 1);
        NA_KLOAD(fb, 3); NA_SCORE(fa, 2);
        NA_KLOAD(fa, 4); NA_SCORE(fb, 3);
        NA_KLOAD(fb, 5); NA_SCORE(fa, 4);
        NA_KLOAD(fa, 6); NA_SCORE(fb, 5);
        NA_KLOAD(fb, 7); NA_SCORE(fa, 6);
        NA_KLOAD(fa, 8); NA_SCORE(fb, 7);
        NA_VLOAD(fb, 0); NA_SCORE(fa, 8);
        mx = fmaxf(mx, sxor(mx, 16)); mx = fmaxf(mx, sxor(mx, 32));
        NA_VLOAD(fa, 1); NA_PV(fb, 0);
        NA_VLOAD(fb, 2); NA_PV(fa, 1);
        NA_VLOAD(fa, 3); NA_PV(fb, 2);
        NA_VLOAD(fb, 4); NA_PV(fa, 3);
        NA_VLOAD(fa, 5); NA_PV(fb, 4);
        NA_VLOAD(fb, 6); NA_PV(fa, 5);
        NA_VLOAD(fa, 7); NA_PV(fb, 6);
        NA_VLOAD(fb, 8); NA_PV(fa, 7);
        NA_PV(fb, 8);
    } else {
        NA_KLOAD(fa, 8); NA_VLOAD(fb, 8); NA_SCORE(fa, 8);
        mx = fmaxf(mx, sxor(mx, 16)); mx = fmaxf(mx, sxor(mx, 32));
        NA_PV(fb, 8);
    }
    sum += sxor(sum, 16); sum += sxor(sum, 32);
    const float inv = 1.0f / sum;
    bf16_t* op = mix + (size_t)(qtok + jq) * DM + h * 128 + 4 * q;
#pragma unroll
    for (int dt = 0; dt < 8; ++dt) { u32x2 w; w.x = pk2(o[dt][0] * inv, o[dt][1] * inv); w.y = pk2(o[dt][2] * inv, o[dt][3] * inv); *(u32x2*)(op + 16 * dt) = w; }
}
__device__ __forceinline__ void na_phase(const Params& p, LAS unsigned char* lds, unsigned* ctr, int wv) {
    const int tid = phase_tid(wv), lane = tid & 63;
    LAS float* rbt = (LAS float*)lds;
    __syncthreads();
    for (int i = tid; i < 8 * 15 * 31; i += 512) rbt[i] = p.in[8][i] * LOG2E;
    __syncthreads();
    for (;;) {
        int id = 0;
        if (lane == 0) id = (int)atomicAdd(ctr, 1u);
        id = __builtin_amdgcn_readfirstlane(id);
        if (id >= NA_UNITS) break;
        na_unit(p, id, lane, rbt);
    }
}

typedef short v4i16_t __attribute__((ext_vector_type(4)));
__device__ __forceinline__ bf16x8 gather8_tr(const LAS bf16_t* tile, int row0, int stride, int col0, int lane) {
    const int qq = (lane & 15) >> 2, pp = lane & 3;
    const LAS bf16_t* a0 = tile + (row0 + qq) * stride + col0 + 4 * pp;
    const v4i16_t lo = __builtin_amdgcn_ds_read_tr16_b64_v4i16((LAS v4i16_t*)a0);
    const v4i16_t hi = __builtin_amdgcn_ds_read_tr16_b64_v4i16((LAS v4i16_t*)(a0 + 4 * stride));
    return (bf16x8){lo[0], lo[1], lo[2], lo[3], hi[0], hi[1], hi[2], hi[3]};
}
__device__ __forceinline__ bf16x8 gather8(const LAS bf16_t* ptr, int stride) {
    bf16x8 r;
#pragma unroll
    for (int e = 0; e < 8; ++e) r[e] = (short)ptr[e * stride];
    return r;
}
constexpr size_t GA_STRIDE = (size_t)8 * MPAD;
constexpr size_t OFF_PT = OFF_TR + 65 * MiB;
static_assert(OFF_PT + (size_t)16 * 257 * 8192 <= 1000 * MiB, "map");
__device__ __forceinline__ void ml_pre(const Params& p, LAS unsigned char* lds, int wv) {
    const int tid = phase_tid(wv), lane = tid & 63, w = wv, jq = lane & 15, q = lane >> 4;
    const bf16_t* nat = (const bf16_t*)(p.ws + OFF_NAT);
    float* ga = (float*)(p.ws + OFF_ELAST);
    bf16_t* pt_out = (bf16_t*)(p.ws + OFF_PT);
    LAS bf16_t* Qs = (LAS bf16_t*)lds; LAS bf16_t* Ks = (LAS bf16_t*)(lds + 17408); LAS float* gl = (LAS float*)(lds + 34816);
    for (int unit = blockIdx.x; unit < NB * 4 * 257; unit += gridDim.x) {
        const int ci = unit % 257, r = unit / 257, h = r & 3, b = r >> 2;
        const int g0 = ci == 0 ? b * T : b * T + 16 + 64 * (ci - 1), c = ci == 0 ? 16 : 64;
#pragma unroll
        for (int i = 0; i < 2; ++i) { const int u = tid + 512 * i, row = u >> 4, oc = u & 15;
            u32x4 vq = (u32x4){0u, 0u, 0u, 0u}, vk = vq;
            if (row < c) { const bf16_t* rp = nat + (size_t)(g0 + row) * NAT0 + h * 128 + 8 * oc; vq = *(const u32x4*)(rp + C_QML); vk = *(const u32x4*)(rp + C_KML); }
            *(LAS u32x4*)(Qs + row * 136 + 8 * oc) = vq; *(LAS u32x4*)(Ks + row * 136 + 8 * oc) = vk; }
        if (w < 2) { const int dir = w; const bool valid = lane < c;
            float ig = -INFINITY, lf = 0.f;
            if (valid) { const bf16_t* gp = nat + (size_t)(g0 + lane) * NAT0 + C_GML;
                ig = bf1(gp[(2 * dir) * 4 + h]) + p.in[5][(2 * dir) * 4 + h];
                lf = log_sigmoid(bf1(gp[(2 * dir + 1) * 4 + h]) + p.in[5][(2 * dir + 1) * 4 + h]); }
            float bc = lf;
            if (dir == 0) {
#pragma unroll
                for (int o = 1; o < 64; o <<= 1) { const float t = sup(bc, o); if (lane >= o) bc += t; }
            } else {
#pragma unroll
                for (int o = 1; o < 64; o <<= 1) { const float t = sdown(bc, o); if (lane + o < 64) bc += t; }
            }
            const float a = valid ? ig - bc : -INFINITY;
            float rm = a;
            if (dir == 0) {
#pragma unroll
                for (int o = 1; o < 64; o <<= 1) { const float t = sup(rm, o); if (lane >= o) rm = fmaxf(rm, t); }
            } else {
#pragma unroll
                for (int o = 1; o < 64; o <<= 1) { const float t = sdown(rm, o); if (lane + o < 64) rm = fmaxf(rm, t); }
            }
            gl[dir * 128 + lane] = a; gl[dir * 128 + 64 + lane] = rm;
            if (valid) { const size_t o = (size_t)(dir * 4 + h) * MPAD + g0 + lane; ga[o] = a; ga[GA_STRIDE + o] = rm; ga[2 * GA_STRIDE + o] = bc; }
        }
        __syncthreads();
        {
            const int si = w & 3, tp = w >> 2;
            f32x4 a0 = (f32x4){0.f, 0.f, 0.f, 0.f}, a1 = a0;
#pragma unroll
            for (int kk = 0; kk < 4; ++kk) { const bf16x8 af = *(const LAS bf16x8*)(Ks + (16 * si + jq) * 136 + 32 * kk + 8 * q);
                a0 = mfma16(af, *(const LAS bf16x8*)(Qs + (16 * (2 * tp) + jq) * 136 + 32 * kk + 8 * q), a0);
                a1 = mfma16(af, *(const LAS bf16x8*)(Qs + (16 * (2 * tp + 1) + jq) * 136 + 32 * kk + 8 * q), a1); }
#pragma unroll
            for (int dir = 0; dir < 2; ++dir) {
                const f32x4 av4 = *(const LAS f32x4*)(gl + dir * 128 + 16 * si + 4 * q);
                bf16_t* po = pt_out + ((size_t)((dir * 4 + h) * 2 + b) * 257 + ci) * 4096;
#pragma unroll
                for (int tt = 0; tt < 2; ++tt) { const int t = 16 * (2 * tp + tt) + jq; const f32x4 a = tt == 0 ? a0 : a1; const float rmt = gl[dir * 128 + 64 + t]; float pv[4];
#pragma unroll
                    for (int rho = 0; rho < 4; ++rho) { const int s = 16 * si + 4 * q + rho;
                        const bool ok = (dir == 0 ? s <= t : s >= t) && s < c && t < c;
                        pv[rho] = ok ? __expf(av4[rho] - rmt) * a[rho] : 0.f; }
                    u32x2 wv2; wv2.x = pg8::cvt_pk_bf16(pv[0], pv[1]); wv2.y = pg8::cvt_pk_bf16(pv[2], pv[3]);
                    *(u32x2*)(po + t * 64 + 16 * si + 4 * q) = wv2; }
            }
        }
        __syncthreads();
    }
}
__device__ __forceinline__ void mlstm_scan(const Params& p, LAS unsigned char* lds, int idx, int wv) {
    const int tid = phase_tid(wv), lane = tid & 63, w = wv, jq = lane & 15, q = lane >> 4;
    const int sl = idx & 7, dir = (idx >> 3) & 1, h = (idx >> 4) & 3, b = idx >> 6;
    const bf16_t* nat = (const bf16_t*)(p.ws + OFF_NAT);
    const float* ga = (const float*)(p.ws + OFF_ELAST) + (size_t)(dir * 4 + h) * MPAD;
    const bf16_t* ptb = (const bf16_t*)(p.ws + OFF_PT) + (size_t)((dir * 4 + h) * 2 + b) * 257 * 4096;
    bf16_t* outp = (bf16_t*)(p.ws + OFF_HB) + (size_t)256 * DM + (size_t)dir * MPAD * 1024;
    constexpr int O_K = 17408, O_VT = 34816, O_VW = 39424, O_P = 46336, O_G = 55552, BUFB = 56064;
    constexpr int O_CT = 2 * BUFB, CTB = 48 * 136 * 2;
    LAS float* mch = (LAS float*)(lds + O_CT + 2 * CTB);
    LAS float* tmpf = mch + 260;
    for (int i = tid; i < 2 * CTB / 4; i += 512) ((LAS unsigned*)(lds + O_CT))[i] = 0u;
    for (int i = tid; i < 2 * 16 * 72 / 2; i += 512) { const int bb = i / (16 * 72 / 2), j = i % (16 * 72 / 2); ((LAS unsigned*)(lds + bb * BUFB + O_VW + 32 * 144))[j] = 0u; }
    if (tid < 257) { const int n = tid, ci = dir == 0 ? n : (n == 256 ? 0 : 256 - n);
        const int g0 = ci == 0 ? b * T : b * T + 16 + 64 * (ci - 1), c = ci == 0 ? 16 : 64;
        const int lastt = dir == 0 ? g0 + c - 1 : g0;
        tmpf[n] = ga[2 * GA_STRIDE + lastt]; tmpf[260 + n] = ga[GA_STRIDE + lastt]; }
    __syncthreads();
    if (tid == 0) { float m = 0.f; for (int n = 0; n < 257; ++n) { mch[n] = m; m = tmpf[n] + fmaxf(m, tmpf[260 + n]); } }
    f32x4 cst[3] = {(f32x4){0.f, 0.f, 0.f, 0.f}, (f32x4){0.f, 0.f, 0.f, 0.f}, (f32x4){0.f, 0.f, 0.f, 0.f}};
    u32x4 rq[2][2], rk[2][2], rv[2], rp[2]; float rg0[2], rg1[2], rg2[2], rgm[2];
    rv[0] = (u32x4){0u, 0u, 0u, 0u}; rv[1] = rv[0]; rg0[0] = rg0[1] = 0.f; rg1[0] = rg1[1] = 0.f; rg2[0] = rg2[1] = 0.f; rgm[0] = rgm[1] = 0.f;
#define ML_CHUNK(n_, g0_, c_, ci_) do { ci_ = dir == 0 ? (n_) : ((n_) == 256 ? 0 : 256 - (n_)); \
        if (ci_ == 0) { g0_ = b * T; c_ = 16; } else { g0_ = b * T + 16 + 64 * (ci_ - 1); c_ = 64; } } while (0)
#define ML_ISSUE(n_, S_) do { int g0i, ci_i, cix; ML_CHUNK(n_, g0i, ci_i, cix); \
        _Pragma("unroll") for (int i = 0; i < 2; ++i) { const int u = tid + 512 * i, row = u >> 4, oc = u & 15; \
            if (row < ci_i) { const bf16_t* rp_ = nat + (size_t)(g0i + row) * NAT0 + h * 128 + 8 * oc; rq[S_][i] = *(const u32x4*)(rp_ + C_QML); rk[S_][i] = *(const u32x4*)(rp_ + C_KML); } \
            else { rq[S_][i] = (u32x4){0u, 0u, 0u, 0u}; rk[S_][i] = rq[S_][i]; } } \
        rp[S_] = *(const u32x4*)(ptb + (size_t)cix * 4096 + 8 * tid); \
        if (tid < 256) { const int row = tid >> 2, pt = tid & 3; \
            if (row < ci_i) { rv[S_] = *(const u32x4*)(nat + (size_t)(g0i + row) * NAT0 + C_VML + h * 256 + sl * 32 + 8 * pt); rg0[S_] = ga[g0i + row]; } \
            else { rv[S_] = (u32x4){0u, 0u, 0u, 0u}; rg0[S_] = -INFINITY; } \
            rgm[S_] = ga[GA_STRIDE + (dir == 0 ? g0i + ci_i - 1 : g0i)]; } \
        if (tid < 64) { if (tid < ci_i) { rg1[S_] = ga[GA_STRIDE + g0i + tid]; rg2[S_] = ga[2 * GA_STRIDE + g0i + tid]; } else { rg1[S_] = -INFINITY; rg2[S_] = 0.f; } } } while (0)
#define ML_STAGE(n_, S_) do { LAS unsigned char* B_ = lds + ((n_) & 1) * BUFB; \
        _Pragma("unroll") for (int i = 0; i < 2; ++i) { const int u = tid + 512 * i, row = u >> 4, oc = u & 15; \
            *(LAS u32x4*)((LAS bf16_t*)B_ + row * 136 + 8 * oc) = rq[S_][i]; *(LAS u32x4*)((LAS bf16_t*)(B_ + O_K) + row * 136 + 8 * oc) = rk[S_][i]; } \
        *(LAS u32x4*)((LAS bf16_t*)(B_ + O_P) + (tid >> 3) * 72 + 8 * (tid & 7)) = rp[S_]; \
        if (tid < 256) { const int row = tid >> 2, pt = tid & 3; const float wt = __expf(rg0[S_] - fmaxf(mch[n_], rgm[S_])); \
            LAS bf16_t* vt_ = (LAS bf16_t*)(B_ + O_VT) + (8 * pt) * 72 + row; LAS bf16_t* vw_ = (LAS bf16_t*)(B_ + O_VW) + (8 * pt) * 72 + row; \
            const unsigned vv_[4] = {rv[S_].x, rv[S_].y, rv[S_].z, rv[S_].w}; \
            _Pragma("unroll") for (int e = 0; e < 4; ++e) { const unsigned ww_ = pg8::cvt_pk_bf16(bflo(vv_[e]) * wt, bfhi(vv_[e]) * wt); \
                vt_[(2 * e) * 72] = (bf16_t)(vv_[e] & 0xffffu); vt_[(2 * e + 1) * 72] = (bf16_t)(vv_[e] >> 16); \
                vw_[(2 * e) * 72] = (bf16_t)(ww_ & 0xffffu); vw_[(2 * e + 1) * 72] = (bf16_t)(ww_ >> 16); } \
            if (pt == 0) ((LAS bf16_t*)(B_ + O_VW))[32 * 72 + row] = (bf16_t)(pg8::cvt_pk_bf16(wt, wt) & 0xffffu); } \
        if (tid < 64) { LAS float* gv_ = (LAS float*)(B_ + O_G); gv_[tid] = rg1[S_]; gv_[64 + tid] = rg2[S_]; } } while (0)
#define ML_STEP(n_, P_) do { \
        int g0, c, ci; ML_CHUNK(n_, g0, c, ci); (void)ci; \
        LAS unsigned char* Bc = lds + (P_) * BUFB; \
        LAS bf16_t* Qs = (LAS bf16_t*)Bc; LAS bf16_t* Ks = (LAS bf16_t*)(Bc + O_K); LAS bf16_t* VT = (LAS bf16_t*)(Bc + O_VT); LAS bf16_t* VW = (LAS bf16_t*)(Bc + O_VW); \
        LAS bf16_t* Ps = (LAS bf16_t*)(Bc + O_P); LAS float* gv = (LAS float*)(Bc + O_G); \
        LAS bf16_t* CTc = (LAS bf16_t*)(lds + O_CT + (P_) * CTB); LAS bf16_t* CTn = (LAS bf16_t*)(lds + O_CT + ((P_) ^ 1) * CTB); \
        if ((n_) + 1 < 257) ML_STAGE((n_) + 1, (P_) ^ 1); \
        if ((n_) + 3 < 257) ML_ISSUE((n_) + 3, (P_) ^ 1); \
        const float m = mch[n_]; \
        const float mlast = fmaxf(m, dir == 0 ? gv[c - 1] : gv[0]); \
        const int oei = w & 1, oti = w >> 1; \
        { \
            f32x4 d1 = (f32x4){0.f, 0.f, 0.f, 0.f}, d2 = d1, dn = d1, dp = d1; \
            const bf16x8 ones = (bf16x8){0x3f80, 0x3f80, 0x3f80, 0x3f80, 0x3f80, 0x3f80, 0x3f80, 0x3f80}; \
        _Pragma("unroll") \
            for (int kk = 0; kk < 4; ++kk) { const bf16x8 qfr = *(const LAS bf16x8*)(Qs + (16 * oti + jq) * 136 + 32 * kk + 8 * q); \
                d1 = mfma16(*(const LAS bf16x8*)(CTc + (16 * oei + jq) * 136 + 32 * kk + 8 * q), qfr, d1); \
                dn = mfma16(*(const LAS bf16x8*)(CTc + 32 * 136 + 32 * kk + 8 * q), qfr, dn); } \
        _Pragma("unroll") \
            for (int ks = 0; ks < 2; ++ks) { const bf16x8 pfr = *(const LAS bf16x8*)(Ps + (16 * oti + jq) * 72 + 32 * ks + 8 * q); \
                d2 = mfma16(*(const LAS bf16x8*)(VT + (16 * oei + jq) * 72 + 32 * ks + 8 * q), pfr, d2); \
                dp = mfma16(ones, pfr, dp); } \
            const int t = 16 * oti + jq; \
            if (t < c) { const float rmt = gv[t], mtt = fmaxf(m, rmt); const float wp = __expf(m - mtt), rr = __expf(rmt - mtt), emt = __expf(-(gv[64 + t] + mtt)); \
                const float den = wp * dn[0] + rr * dp[0]; const float iv = __builtin_amdgcn_rcpf(fmaxf(fabsf(den), emt)); u32x2 wv2; \
                wv2.x = pg8::cvt_pk_bf16((wp * d1[0] + rr * d2[0]) * iv, (wp * d1[1] + rr * d2[1]) * iv); wv2.y = pg8::cvt_pk_bf16((wp * d1[2] + rr * d2[2]) * iv, (wp * d1[3] + rr * d2[3]) * iv); \
                *(u32x2*)(outp + (size_t)(g0 + t) * 1024 + h * 256 + sl * 32 + 16 * oei + 4 * q) = wv2; } \
        } \
        { const float wst = __expf(m - mlast); \
          f32x4 dacc[3] = {(f32x4){0.f, 0.f, 0.f, 0.f}, (f32x4){0.f, 0.f, 0.f, 0.f}, (f32x4){0.f, 0.f, 0.f, 0.f}}; \
        _Pragma("unroll") \
          for (int ks = 0; ks < 2; ++ks) { const bf16x8 af = gather8_tr(Ks, 32 * ks + 8 * q, 136, 16 * w, lane); \
        _Pragma("unroll") \
              for (int ej = 0; ej < 3; ++ej) dacc[ej] = mfma16(af, *(const LAS bf16x8*)(VW + (16 * ej + jq) * 72 + 32 * ks + 8 * q), dacc[ej]); } \
        _Pragma("unroll") \
          for (int ej = 0; ej < 3; ++ej) { cst[ej] = cst[ej] * wst + dacc[ej]; u32x2 wv2; wv2.x = pg8::cvt_pk_bf16(cst[ej][0], cst[ej][1]); wv2.y = pg8::cvt_pk_bf16(cst[ej][2], cst[ej][3]); \
              *(LAS u32x2*)(CTn + (16 * ej + jq) * 136 + 16 * w + 4 * q) = wv2; } } \
        BAR_LDS(); \
    } while (0)
    __syncthreads();
    ML_ISSUE(0, 0);
    ML_STAGE(0, 0);
    ML_ISSUE(1, 1);
    ML_ISSUE(2, 0);
    __syncthreads();
    for (int n = 0; n < 256; n += 2) { ML_STEP(n, 0); ML_STEP(n + 1, 1); }
    ML_STEP(256, 0);
    __syncthreads();
#undef ML_CHUNK
#undef ML_ISSUE
#undef ML_STAGE
#undef ML_STEP
}

__device__ __forceinline__ void post0_phase(const Params& p, int wv) {
    const int tid = phase_tid(wv), lane = tid & 63, wave = tid >> 6;
    const int gw = blockIdx.x * 8 + wave, NGW = gridDim.x * 8;
    const bf16_t* hf = (const bf16_t*)(p.ws + OFF_HB) + (size_t)256 * DM; const bf16_t* hbw = hf + (size_t)MPAD * 1024;
    const bf16_t* nat = (const bf16_t*)(p.ws + OFF_NAT);
    bf16_t* mix = (bf16_t*)(p.ws + OFF_MIX);
    for (int it = gw; it < M * 4; it += NGW) { const int g = it >> 2, hh = it & 3, col = hh * 256 + 4 * lane;
        const u32x2 a = *(const u32x2*)(hf + (size_t)g * 1024 + col), c = *(const u32x2*)(hbw + (size_t)g * 1024 + col), ov = *(const u32x2*)(nat + (size_t)g * NAT0 + C_OML + col);
        float v[4] = {bflo(a.x) + bflo(c.x), bfhi(a.x) + bfhi(c.x), bflo(a.y) + bflo(c.y), bfhi(a.y) + bfhi(c.y)};
        const float o[4] = {bflo(ov.x), bfhi(ov.x), bflo(ov.y), bfhi(ov.y)};
        const float s = wave_sum((v[0] * v[0] + v[1] * v[1]) + (v[2] * v[2] + v[3] * v[3]));
        const float rs = rsqrtf(s * (1.0f / 256.0f) + EPS); const f32x4 gn = *(const f32x4*)(p.in[9] + col);
#pragma unroll
        for (int e = 0; e < 4; ++e) v[e] = v[e] * rs * gn[e] * __builtin_amdgcn_rcpf(1.0f + __expf(-o[e]));
        u32x2 wv; wv.x = pk2(v[0], v[1]); wv.y = pk2(v[2], v[3]); *(u32x2*)(mix + (size_t)g * DM + 1024 + col) = wv; }
}

__device__ __forceinline__ void gla_pre(const Params& p, LAS unsigned char* lds, int wv) {
    const int tid = phase_tid(wv);
    bf16_t* nat = (bf16_t*)(p.ws + OFF_NAT);
    bf16_t* qb = (bf16_t*)(p.ws + OFF_W0); bf16_t* kb = qb + (size_t)MPAD * 1024;
    float* elast = (float*)(p.ws + OFF_ELAST);
    LAS bf16_t* qs = (LAS bf16_t*)lds; LAS bf16_t* ks = (LAS bf16_t*)(lds + 32768); LAS float* lrs = (LAS float*)(lds + 65536);
    for (int unit = blockIdx.x; unit < NB * 257 * 4; unit += gridDim.x) {
        const int h = unit & 3, ci = (unit >> 2) % 257, b = (unit >> 2) / 257;
        const int g0 = ci == 0 ? b * T : b * T + 16 + 64 * (ci - 1), c = ci == 0 ? 16 : 64;
#pragma unroll
        for (int i = 0; i < 4; ++i) { const int u = tid + 512 * i, row = u >> 5, oc = u & 31;
            u32x4 vq = (u32x4){0u, 0u, 0u, 0u}, vk = vq;
            if (row < c) { const bf16_t* rp = nat + (size_t)(g0 + row) * NAT1 + h * 256 + 8 * oc; vq = *(const u32x4*)(rp + C_GQ); vk = *(const u32x4*)(rp + C_GK); }
            *(LAS u32x4*)(qs + row * 256 + 8 * oc) = vq; *(LAS u32x4*)(ks + row * 256 + 8 * oc) = vk; }
        { const int row = tid >> 3, c4 = (tid & 7) * 4;
          if (row < c) { const u32x2 v = *(const u32x2*)(nat + (size_t)(g0 + row) * NAT1 + C_GLR + c4);
              lrs[row * 32 + c4] = bflo(v.x); lrs[row * 32 + c4 + 1] = bfhi(v.x); lrs[row * 32 + c4 + 2] = bflo(v.y); lrs[row * 32 + c4 + 3] = bfhi(v.y); } }
        __syncthreads();
        { const int d = tid & 255, dr = tid >> 8;
          float gu[16];
#pragma unroll
          for (int r = 0; r < 16; ++r) gu[r] = p.in[12][(size_t)(dr * 16 + r) * 1024 + h * 256 + d];
          const float gb = p.in[13][dr * 1024 + h * 256 + d];
          bf16_t* qo = dr == 0 ? nat + C_GQ : qb; bf16_t* ko = dr == 0 ? nat + C_GK : kb; const int ldo = dr == 0 ? NAT1 : 1024;
          float run = 0.f;
          for (int st = 0; st < c; ++st) { const int s = dr == 0 ? st : c - 1 - st;
              float x = gb;
#pragma unroll
              for (int r = 0; r < 16; ++r) x += lrs[s * 32 + dr * 16 + r] * gu[r];
              run += log_sigmoid(x) * (1.0f / 16.0f);
              const float E = __expf(run);
              const float qv = bf1(qs[s * 256 + d]) * E, kv = bf1(ks[s * 256 + d]) * __builtin_amdgcn_rcpf(E);
              qo[(size_t)(g0 + s) * ldo + h * 256 + d] = (bf16_t)f2bf(qv); ko[(size_t)(g0 + s) * ldo + h * 256 + d] = (bf16_t)f2bf(kv); }
          elast[((size_t)((dr * 2 + b) * 257 + ci) * 4 + h) * 256 + d] = __expf(run); }
        __syncthreads();
    }
}
__device__ __forceinline__ void gla_pre2(const Params& p, LAS unsigned char* lds, int wv) {
    const int tid = phase_tid(wv), lane = tid & 63, w = wv, jq = lane & 15, q = lane >> 4;
    const bf16_t* nat = (const bf16_t*)(p.ws + OFF_NAT);
    bf16_t* at_out = (bf16_t*)(p.ws + OFF_PT);
    LAS bf16_t* Qs = (LAS bf16_t*)lds; LAS bf16_t* Ks = (LAS bf16_t*)(lds + 33792);
    for (int unit = blockIdx.x; unit < 2 * NB * 257 * 4; unit += gridDim.x) {
        const int h = unit & 3, ci = (unit >> 2) % 257, r = (unit >> 2) / 257, b = r & 1, dir = r >> 1;
        const int g0 = ci == 0 ? b * T : b * T + 16 + 64 * (ci - 1), c = ci == 0 ? 16 : 64;
        const bf16_t* qsrc = dir == 0 ? nat + C_GQ : (const bf16_t*)(p.ws + OFF_W0);
        const bf16_t* ksrc = dir == 0 ? nat + C_GK : (const bf16_t*)(p.ws + OFF_W0) + (size_t)MPAD * 1024;
        const int ldq = dir == 0 ? NAT1 : 1024;
#pragma unroll
        for (int i = 0; i < 4; ++i) { const int u = tid + 512 * i, row = u >> 5, oc = u & 31;
            u32x4 vq = (u32x4){0u, 0u, 0u, 0u}, vk = vq;
            if (row < c) { const size_t off = (size_t)(g0 + row) * ldq + h * 256 + 8 * oc; vq = *(const u32x4*)(qsrc + off); vk = *(const u32x4*)(ksrc + off); }
            *(LAS u32x4*)(Qs + row * 264 + 8 * oc) = vq; *(LAS u32x4*)(Ks + row * 264 + 8 * oc) = vk; }
        __syncthreads();
        {
            const int si = w & 3, tp = w >> 2;
            f32x4 a0 = (f32x4){0.f, 0.f, 0.f, 0.f}, a1 = a0;
#pragma unroll
            for (int kk = 0; kk < 8; ++kk) { const bf16x8 af = *(const LAS bf16x8*)(Ks + (16 * si + jq) * 264 + 32 * kk + 8 * q);
                a0 = mfma16(af, *(const LAS bf16x8*)(Qs + (16 * (2 * tp) + jq) * 264 + 32 * kk + 8 * q), a0);
                a1 = mfma16(af, *(const LAS bf16x8*)(Qs + (16 * (2 * tp + 1) + jq) * 264 + 32 * kk + 8 * q), a1); }
            bf16_t* po = at_out + (size_t)unit * 4096;
#pragma unroll
            for (int tt = 0; tt < 2; ++tt) { const int t = 16 * (2 * tp + tt) + jq; const f32x4 a = tt == 0 ? a0 : a1; float pv[4];
#pragma unroll
                for (int rho = 0; rho < 4; ++rho) { const int s = 16 * si + 4 * q + rho;
                    const bool ok = (dir == 0 ? s <= t : s >= t) && s < c && t < c; pv[rho] = ok ? a[rho] : 0.f; }
                u32x2 wv2; wv2.x = pg8::cvt_pk_bf16(pv[0], pv[1]); wv2.y = pg8::cvt_pk_bf16(pv[2], pv[3]);
                *(u32x2*)(po + t * 64 + 16 * si + 4 * q) = wv2; }
        }
        __syncthreads();
    }
}
__device__ __forceinline__ void gla_scan(const Params& p, LAS unsigned char* lds, int idx, int wv) {
    const int tid = phase_tid(wv), lane = tid & 63, w = wv, jq = lane & 15, q = lane >> 4;
    const int sl = idx & 15, dir = (idx >> 4) & 1, h = (idx >> 5) & 3, b = idx >> 7;
    const bf16_t* nat = (const bf16_t*)(p.ws + OFF_NAT);
    const bf16_t* qsrc = dir == 0 ? nat + C_GQ : (const bf16_t*)(p.ws + OFF_W0);
    const bf16_t* ksrc = dir == 0 ? nat + C_GK : (const bf16_t*)(p.ws + OFF_W0) + (size_t)MPAD * 1024;
    const int lds_ = dir == 0 ? NAT1 : 1024;
    const float* elast = (const float*)(p.ws + OFF_ELAST);
    const bf16_t* atb = (const bf16_t*)(p.ws + OFF_PT);
    bf16_t* outp = dir == 0 ? (bf16_t*)(p.ws + OFF_HB) + (size_t)256 * DM : (bf16_t*)(p.ws + OFF_MIX);
    constexpr int O_VT = 33792, O_A = 38400, O_EL = 47616, BUFB = 48640;
    constexpr int O_ST = 2 * BUFB, STB = 32 * 264 * 2;
    for (int i = tid; i < 2 * STB / 4; i += 512) ((LAS unsigned*)(lds + O_ST))[i] = 0u;
    f32x4 sst[4][2];
#pragma unroll
    for (int a = 0; a < 4; ++a)
#pragma unroll
        for (int e = 0; e < 2; ++e) sst[a][e] = (f32x4){0.f, 0.f, 0.f, 0.f};
    const bool owave = w >= 4; const int oti = w & 3;
    u32x4 rk[2][4], rv[2], ra[2]; float rel[2];
    bf16x8 qn[2][8];
    rv[0] = (u32x4){0u, 0u, 0u, 0u}; rv[1] = rv[0]; rel[0] = 0.f; rel[1] = 0.f;
#define GLA_CHUNK(n_, g0_, c_, ci_) do { ci_ = dir == 0 ? (n_) : ((n_) == 256 ? 0 : 256 - (n_)); \
        if (ci_ == 0) { g0_ = b * T; c_ = 16; } else { g0_ = b * T + 16 + 64 * (ci_ - 1); c_ = 64; } } while (0)
#define GLA_ISSUE(n_, S_) do { int g0i, ci_i, cci; GLA_CHUNK(n_, g0i, ci_i, cci); \
        _Pragma("unroll") for (int i = 0; i < 4; ++i) { const int u = tid + 512 * i, row = u >> 5, oc = u & 31; \
            if (row < ci_i) rk[S_][i] = *(const u32x4*)(ksrc + (size_t)(g0i + row) * lds_ + h * 256 + 8 * oc); else rk[S_][i] = (u32x4){0u, 0u, 0u, 0u}; } \
        ra[S_] = *(const u32x4*)(atb + ((size_t)(((dir * 2 + b) * 257 + cci) * 4 + h)) * 4096 + 8 * tid); \
        if (tid < 256) { const int row = tid >> 2, pt = tid & 3; \
            rv[S_] = row < ci_i ? *(const u32x4*)(nat + (size_t)(g0i + row) * NAT1 + C_GV + h * 512 + sl * 32 + 8 * pt) : (u32x4){0u, 0u, 0u, 0u}; \
            rel[S_] = elast[((size_t)((dir * 2 + b) * 257 + cci) * 4 + h) * 256 + tid]; } } while (0)
#define GLA_QISSUE(n_, S_) do { if (owave) { int g0i, ci_i, cci; GLA_CHUNK(n_, g0i, ci_i, cci); (void)ci_i; (void)cci; \
        const bf16_t* qp_ = qsrc + (size_t)(g0i + 16 * oti + jq) * lds_ + h * 256 + 8 * q; \
        _Pragma("unroll") for (int kk = 0; kk < 8; ++kk) qn[S_][kk] = *(const bf16x8*)(qp_ + 32 * kk); } } while (0)
#define GLA_STAGE(n_, S_) do { LAS unsigned char* B_ = lds + ((n_) & 1) * BUFB; \
        _Pragma("unroll") for (int i = 0; i < 4; ++i) { const int u = tid + 512 * i, row = u >> 5, oc = u & 31; *(LAS u32x4*)((LAS bf16_t*)B_ + row * 264 + 8 * oc) = rk[S_][i]; } \
        *(LAS u32x4*)((LAS bf16_t*)(B_ + O_A) + (tid >> 3) * 72 + 8 * (tid & 7)) = ra[S_]; \
        if (tid < 256) { const int row = tid >> 2, pt = tid & 3; LAS bf16_t* vt_ = (LAS bf16_t*)(B_ + O_VT) + (8 * pt) * 72 + row; \
            const unsigned vv_[4] = {rv[S_].x, rv[S_].y, rv[S_].z, rv[S_].w}; \
            _Pragma("unroll") for (int e = 0; e < 4; ++e) { vt_[(2 * e) * 72] = (bf16_t)(vv_[e] & 0xffffu); vt_[(2 * e + 1) * 72] = (bf16_t)(vv_[e] >> 16); } \
            ((LAS float*)(B_ + O_EL))[tid] = rel[S_]; } } while (0)
#define GLA_STEP(n_, P_) do { \
        int g0, c, ci; GLA_CHUNK(n_, g0, c, ci); (void)ci; \
        LAS unsigned char* Bc = lds + (P_) * BUFB; \
        LAS bf16_t* Ks = (LAS bf16_t*)Bc; LAS bf16_t* VT = (LAS bf16_t*)(Bc + O_VT); LAS bf16_t* As = (LAS bf16_t*)(Bc + O_A); LAS float* el = (LAS float*)(Bc + O_EL); \
        LAS bf16_t* STc = (LAS bf16_t*)(lds + O_ST + (P_) * STB); LAS bf16_t* STn = (LAS bf16_t*)(lds + O_ST + ((P_) ^ 1) * STB); \
        if ((n_) + 1 < 257) GLA_STAGE((n_) + 1, (P_) ^ 1); \
        if ((n_) + 3 < 257) GLA_ISSUE((n_) + 3, (P_) ^ 1); \
        if (owave) { \
            f32x4 oa0 = (f32x4){0.f, 0.f, 0.f, 0.f}, oa1 = oa0; \
            _Pragma("unroll") for (int kk = 0; kk < 8; ++kk) { \
                oa0 = mfma16(*(const LAS bf16x8*)(STc + (jq) * 264 + 32 * kk + 8 * q), qn[P_][kk], oa0); \
                oa1 = mfma16(*(const LAS bf16x8*)(STc + (16 + jq) * 264 + 32 * kk + 8 * q), qn[P_][kk], oa1); } \
            if ((n_) + 2 < 257) GLA_QISSUE((n_) + 2, P_); \
            _Pragma("unroll") for (int ks = 0; ks < 2; ++ks) { const bf16x8 afr = *(const LAS bf16x8*)(As + (16 * oti + jq) * 72 + 32 * ks + 8 * q); \
                oa0 = mfma16(*(const LAS bf16x8*)(VT + (jq) * 72 + 32 * ks + 8 * q), afr, oa0); \
                oa1 = mfma16(*(const LAS bf16x8*)(VT + (16 + jq) * 72 + 32 * ks + 8 * q), afr, oa1); } \
            const int t = 16 * oti + jq; \
            if (t < c) { bf16_t* op_ = outp + (size_t)(g0 + t) * DM + h * 512 + sl * 32 + 4 * q; \
                u32x2 wa; wa.x = pg8::cvt_pk_bf16(oa0[0], oa0[1]); wa.y = pg8::cvt_pk_bf16(oa0[2], oa0[3]); *(u32x2*)(op_) = wa; \
                u32x2 wb; wb.x = pg8::cvt_pk_bf16(oa1[0], oa1[1]); wb.y = pg8::cvt_pk_bf16(oa1[2], oa1[3]); *(u32x2*)(op_ + 16) = wb; } \
        } else { \
            bf16x8 vf[2][2]; \
            _Pragma("unroll") for (int ks = 0; ks < 2; ++ks) \
                _Pragma("unroll") for (int ej = 0; ej < 2; ++ej) vf[ks][ej] = *(const LAS bf16x8*)(VT + (16 * ej + jq) * 72 + 32 * ks + 8 * q); \
            _Pragma("unroll") for (int dd = 0; dd < 4; ++dd) { \
                f32x4 dl0 = (f32x4){0.f, 0.f, 0.f, 0.f}, dl1 = dl0; \
                _Pragma("unroll") for (int ks = 0; ks < 2; ++ks) { const bf16x8 af = gather8_tr(Ks, 32 * ks + 8 * q, 264, 16 * (4 * w + dd), lane); \
                    dl0 = mfma16(af, vf[ks][0], dl0); dl1 = mfma16(af, vf[ks][1], dl1); } \
                const int d0 = 16 * (4 * w + dd) + 4 * q; const f32x4 ev = *(const LAS f32x4*)(el + d0); \
                sst[dd][0] = (sst[dd][0] + dl0) * ev; sst[dd][1] = (sst[dd][1] + dl1) * ev; \
                u32x2 w0; w0.x = pg8::cvt_pk_bf16(sst[dd][0][0], sst[dd][0][1]); w0.y = pg8::cvt_pk_bf16(sst[dd][0][2], sst[dd][0][3]); \
                u32x2 w1; w1.x = pg8::cvt_pk_bf16(sst[dd][1][0], sst[dd][1][1]); w1.y = pg8::cvt_pk_bf16(sst[dd][1][2], sst[dd][1][3]); \
                *(LAS u32x2*)(STn + (0 + jq) * 264 + d0) = w0; *(LAS u32x2*)(STn + (16 + jq) * 264 + d0) = w1; \
            } \
        } \
        BAR_LDS(); } while (0)
    __syncthreads();
    GLA_ISSUE(0, 0);
    GLA_STAGE(0, 0);
    GLA_ISSUE(1, 1);
    GLA_ISSUE(2, 0);
    GLA_QISSUE(0, 0);
    GLA_QISSUE(1, 1);
    __syncthreads();
    for (int n = 0; n < 256; n += 2) { GLA_STEP(n, 0); GLA_STEP(n + 1, 1); }
    GLA_STEP(256, 0);
    __syncthreads();
#undef GLA_CHUNK
#undef GLA_ISSUE
#undef GLA_QISSUE
#undef GLA_STAGE
#undef GLA_STEP
}
__device__ __forceinline__ void post1_phase(const Params& p, int wv) {
    const int tid = phase_tid(wv), lane = tid & 63, wave = tid >> 6;
    const int gw = blockIdx.x * 8 + wave, NGW = gridDim.x * 8;
    const bf16_t* of = (const bf16_t*)(p.ws + OFF_HB) + (size_t)256 * DM;
    bf16_t* mix = (bf16_t*)(p.ws + OFF_MIX);
    const bf16_t* nat = (const bf16_t*)(p.ws + OFF_NAT);
    for (int it = gw; it < M * 4; it += NGW) { const int g = it >> 2, hh = it & 3, col = hh * 512 + 8 * lane;
        const u32x4 a = *(const u32x4*)(of + (size_t)g * DM + col), c = *(const u32x4*)(mix + (size_t)g * DM + col), rv = *(const u32x4*)(nat + (size_t)g * NAT1 + C_GR + col);
        float v[8] = {bflo(a.x) + bflo(c.x), bfhi(a.x) + bfhi(c.x), bflo(a.y) + bflo(c.y), bfhi(a.y) + bfhi(c.y), bflo(a.z) + bflo(c.z), bfhi(a.z) + bfhi(c.z), bflo(a.w) + bflo(c.w), bfhi(a.w) + bfhi(c.w)};
        const float r[8] = {bflo(rv.x), bfhi(rv.x), bflo(rv.y), bfhi(rv.y), bflo(rv.z), bfhi(rv.z), bflo(rv.w), bfhi(rv.w)};
        float s = 0.f;
#pragma unroll
        for (int e = 0; e < 8; ++e) s += v[e] * v[e];
        s = wave_sum(s);
        const float rs = rsqrtf(s * (1.0f / 512.0f) + EPS);
        const float* gn = p.in[14] + col;
#pragma unroll
        for (int e = 0; e < 8; ++e) v[e] = v[e] * rs * gn[e] * r[e] * __builtin_amdgcn_rcpf(1.0f + __expf(-r[e]));
        u32x4 wv; wv.x = pk2(v[0], v[1]); wv.y = pk2(v[2], v[3]); wv.z = pk2(v[4], v[5]); wv.w = pk2(v[6], v[7]);
        *(u32x4*)(mix + (size_t)g * DM + col) = wv; }
}

__device__ __forceinline__ void tail_rows(LAS unsigned char* lds, const bf16_t* A, const bf16_t* Bt, int K, const pg8::EpiRes& E, int wv) {
    const int lane = lane_id_v(), jq = lane & 15, q = lane >> 4;
    LAS float* red = (LAS float*)lds;
    for (int j = blockIdx.x; j < 256; j += gridDim.x) {
        const int rt = j >> 7, ct = j & 127, g = 32768 + 16 * rt + jq, kw = K >> 3, k0 = wv * kw;
        const bf16_t* ap = A + (size_t)g * K + k0 + 8 * q; const bf16_t* bp = Bt + (size_t)(16 * ct + jq) * K + k0 + 8 * q;
        f32x4 acc = (f32x4){0.f, 0.f, 0.f, 0.f};
#pragma unroll 4
        for (int k = 0; k < kw; k += 32) acc = mfma16(*(const bf16x8*)(bp + k), *(const bf16x8*)(ap + k), acc);
        *(LAS f32x4*)(red + (wv * 64 + lane) * 4) = acc;
        __syncthreads();
        if (wv == 0) {
            f32x4 v = (f32x4){0.f, 0.f, 0.f, 0.f};
#pragma unroll
            for (int i = 0; i < 8; ++i) v += *(const LAS f32x4*)(red + (i * 64 + lane) * 4);
            const int b = 1, t = g - T, col = 16 * ct + 4 * q;
            const float* sp = E.srcx + ((size_t)b * SEQ + (t - 16)) * DM; float* dp = E.dstx + ((size_t)b * SEQ + (t - 16)) * DM;
            v += *(const f32x4*)(sp + col);
            *(f32x4*)(dp + col) = v;
            if (E.hb) { u32x2 w2; w2.x = pg8::cvt_pk_bf16(v[0], v[1]); w2.y = pg8::cvt_pk_bf16(v[2], v[3]); *(u32x2*)(E.hb + (size_t)g * DM + col) = w2; }
            float ss = (v[0] * v[0] + v[1] * v[1]) + (v[2] * v[2] + v[3] * v[3]);
            ss += sxor(ss, 16); ss += sxor(ss, 32);
            if (E.ssq && q == 0) atomicAdd(E.ssq + g, ss);
        }
        __syncthreads();
    }
}

constexpr size_t OFF_XBAR = 16 * 1024;
constexpr int LDS_XBST = LDS_BYTES - 16;
#define XB_TMO      128
#define XB_XCNT(j)  (256  + 64 * (j))
#define XB_XSUB(j)  (1280 + 64 * (j))
#define XB_XGEN(j)  (2304 + 64 * (j))
#define XB_TOP      3328
#define XB_TOPGEN   3392
#define XCD_BAR_WORDS 3456
#define XB_SPIN_CAP (1u << 18)

__device__ __forceinline__ unsigned xb_ld(unsigned* p)              { return __hip_atomic_load(p, __ATOMIC_RELAXED, __HIP_MEMORY_SCOPE_AGENT); }
__device__ __forceinline__ unsigned xb_add(unsigned* p, unsigned v) { return __hip_atomic_fetch_add(p, v, __ATOMIC_RELAXED, __HIP_MEMORY_SCOPE_AGENT); }
__device__ __forceinline__ unsigned xb_xcc_id() { return (unsigned)__builtin_amdgcn_s_getreg((3 << 11) | 20) & 0xFu; }
#define XB_SPIN(cond, bar) do { unsigned _sp = 0; while (cond) { __builtin_amdgcn_s_sleep(1); \
    if ((++_sp & 255u) == 0u) { if (xb_ld(&(bar)[XB_TMO])) break; if (_sp > XB_SPIN_CAP) { atomicAdd(&(bar)[XB_TMO], 1u); break; } } } } while (0)

struct XcdBarrier {
    unsigned* bar; unsigned x;
    volatile LAS unsigned* st;
};

__device__ __forceinline__ XcdBarrier xcd_barrier_post(unsigned* bar, volatile LAS unsigned* st) {
    XcdBarrier b; b.bar = bar; b.x = xb_xcc_id(); b.st = st;
    if (threadIdx.x == 0) (void)xb_add(&bar[XB_XCNT(b.x)], 1u);
    return b;
}
__device__ __forceinline__ void xcd_barrier_complete(unsigned* bar, unsigned x, unsigned& nloc, unsigned& nx) {
    const unsigned G = gridDim.x * gridDim.y * gridDim.z;
    unsigned sum, cnt, mine, sp = 0u;
    for (;;) {
        sum = 0u; cnt = 0u; mine = 0u;
#pragma unroll
        for (unsigned j = 0; j < 16; ++j) { const unsigned c = xb_ld(&bar[XB_XCNT(j)]); sum += c; cnt += (c > 0u) ? 1u : 0u; mine = (j == x) ? c : mine; }
        if (sum == G) break;
        __builtin_amdgcn_s_sleep(1);
        if ((++sp & 255u) == 0u) { if (xb_ld(&bar[XB_TMO])) break; if (sp > XB_SPIN_CAP) { atomicAdd(&bar[XB_TMO], 1u); break; } }
    }
    nloc = mine > 0u ? mine : 1u; nx = cnt > 0u ? cnt : 1u;
}

__device__ __forceinline__ void xcd_barrier(const XcdBarrier& b) {
    asm volatile("s_waitcnt vmcnt(0)" ::: "memory");
    __syncthreads();
    if (threadIdx.x == 0) {
        unsigned* bar = b.bar;
        __builtin_amdgcn_s_waitcnt(0);
        unsigned nloc = b.st[0], nx = b.st[1];
        if (nloc == 0u) { xcd_barrier_complete(bar, b.x, nloc, nx); b.st[0] = nloc; b.st[1] = nx; }
        const unsigned old = xb_add(&bar[XB_XSUB(b.x)], 1u);
        const unsigned gen = old / nloc;
        if (old + 1u == (gen + 1u) * nloc) {
            __builtin_amdgcn_fence(__ATOMIC_RELEASE, "agent");
            asm volatile("s_waitcnt vmcnt(0)" ::: "memory");
            const unsigned og = xb_add(&bar[XB_TOP], 1u);
            const unsigned tg = og / nx;
            if (og + 1u == (tg + 1u) * nx) xb_add(&bar[XB_TOPGEN], 1u);
            else XB_SPIN(xb_ld(&bar[XB_TOPGEN]) == tg, bar);
            __builtin_amdgcn_fence(__ATOMIC_ACQUIRE, "agent");
            xb_add(&bar[XB_XGEN(b.x)], 1u);
            asm volatile("s_waitcnt vmcnt(0)" ::: "memory");
        } else {
            XB_SPIN(xb_ld(&bar[XB_XGEN(b.x)]) == gen, bar);
            __builtin_amdgcn_fence(__ATOMIC_ACQUIRE, "agent");
            asm volatile("s_waitcnt vmcnt(0)" ::: "memory");
        }
    }
    __syncthreads();
}

__global__ void __launch_bounds__(512, 2) fwd_megakernel(Params p) {
    extern __shared__ __attribute__((aligned(16))) unsigned char lds_raw[];
    LAS unsigned char* lds = (LAS unsigned char*)lds_raw;
    cg::grid_group grid = cg::this_grid();
    const int wv = __builtin_amdgcn_readfirstlane((int)(threadIdx.x >> 6));
    if (threadIdx.x < 2) ((LAS unsigned*)(lds + LDS_XBST))[threadIdx.x] = 0u;
    __syncthreads();
    const XcdBarrier xbar = xcd_barrier_post((unsigned*)(p.ws + OFF_CTL + OFF_XBAR), (volatile LAS unsigned*)(lds + LDS_XBST));
    unsigned char* ws = p.ws;
    const int G = gridDim.x, bx = blockIdx.x;
    bf16_t* hb = (bf16_t*)(ws + OFF_HB) + (size_t)256 * DM;
    bf16_t* nat = (bf16_t*)(ws + OFF_NAT);
    bf16_t* act = (bf16_t*)(ws + OFF_NAT);
    bf16_t* mix = (bf16_t*)(ws + OFF_MIX);
    float* ssq = (float*)(ws + OFF_SSQ);
    float* hmeta = (float*)(ws + OFF_HMETA);
    unsigned* ctr = (unsigned*)(ws + OFF_CTL);
    LAS float* xl = (LAS float*)(lds + LDS_XCH);

    p0_prologue(p, lds, wv);
    grid.sync();
    { pg8::Gemm g{hb, (const bf16_t*)(ws + OFF_W0 + W_NAT0), DM}; pg8::Order S; S.init(NMT, NAT0 / 256, G, bx, 0);
      pg8::EpiScale E{nat, NAT0, ssq}; pg8::gemm_phase(lds, g, S, E, wv); }
    { pg8::Gemm g{(const bf16_t*)(ws + OFF_W0 + W_TR0), hb, DM}; pg8::Order S; S.init(4, NMT, G, bx, 0);
      pg8::EpiScaleT E{(bf16_t*)(ws + OFF_TR), ssq}; pg8::gemm_phase(lds, g, S, E, wv); }
    xcd_barrier(xbar);
    qknorm_phase(p, wv);
    ml_pre(p, lds, wv);
    xcd_barrier(xbar);
#ifndef NO_ML
    for (int idx = bx; idx < 128; idx += G) mlstm_scan(p, lds, G == 256 ? ((idx & 7) * 16 + (idx >> 3)) : idx, wv);
#endif
#ifndef NO_NA
    na_phase(p, lds, ctr, wv);
#endif
    xcd_barrier(xbar);
    post0_phase(p, wv);
    xcd_barrier(xbar);
    { pg8::Gemm g{mix, (const bf16_t*)(ws + OFF_W0 + W_OUT0), DM}; pg8::Order S; S.init(NMT - 1, 8, G, bx, 0);
      pg8::EpiRes E{p.in[0], hmeta, p.out, hmeta, hb, ssq + MPAD}; tail_rows(lds, g.A, g.Bt, g.K, E, wv); pg8::gemm_phase(lds, g, S, E, wv); }
    xcd_barrier(xbar);
    { pg8::Gemm g{hb, (const bf16_t*)(ws + OFF_W0 + W_UP0), DM}; pg8::Order S; S.init(130, 44, G, bx, 1);
      pg8::EpiFfn E{act, ssq + MPAD, p.in[17], p.in[18], xl};
#ifndef NO_FFN
      pg8::gemm_phase(lds, g, S, E, wv);
#endif
    }
    xcd_barrier(xbar);
    { pg8::Gemm g{act, (const bf16_t*)(ws + OFF_W0 + W_DN0), FF}; pg8::Order S; S.init(NMT - 1, 8, G, bx, 0);
      pg8::EpiRes E{p.out, hmeta, p.out, hmeta, hb, ssq + 2 * MPAD}; tail_rows(lds, g.A, g.Bt, g.K, E, wv); pg8::gemm_phase(lds, g, S, E, wv); }
    xcd_barrier(xbar);
    { pg8::Gemm g{hb, (const bf16_t*)(ws + OFF_W1 + W_NAT1), DM}; pg8::Order S; S.init(NMT, NAT1 / 256, G, bx, 0);
      pg8::EpiScale E{nat, NAT1, ssq + 2 * MPAD}; pg8::gemm_phase(lds, g, S, E, wv); }
    xcd_barrier(xbar);
#ifndef NO_GP
    gla_pre(p, lds, wv);
#endif
    xcd_barrier(xbar);
    gla_pre2(p, lds, wv);
    xcd_barrier(xbar);
#ifndef NO_GS
    for (int idx = bx; idx < 256; idx += G) gla_scan(p, lds, G == 256 ? ((idx & 7) * 32 + (idx >> 3)) : idx, wv);
#endif
    xcd_barrier(xbar);
    post1_phase(p, wv);
    xcd_barrier(xbar);
    { pg8::Gemm g{mix, (const bf16_t*)(ws + OFF_W1 + W_OUT1), DM}; pg8::Order S; S.init(NMT - 1, 8, G, bx, 0);
      pg8::EpiRes E{p.out, hmeta, p.out, hmeta, hb, ssq + 3 * MPAD}; tail_rows(lds, g.A, g.Bt, g.K, E, wv); pg8::gemm_phase(lds, g, S, E, wv); }
    xcd_barrier(xbar);
    { pg8::Gemm g{hb, (const bf16_t*)(ws + OFF_W1 + W_UP1), DM}; pg8::Order S; S.init(130, 44, G, bx, 1);
      pg8::EpiFfn E{act, ssq + 3 * MPAD, p.in[17] + 3 * FF2, p.in[18] + FF2, xl};
#ifndef NO_FFN
      pg8::gemm_phase(lds, g, S, E, wv);
#endif
    }
    xcd_barrier(xbar);
    { pg8::Gemm g{act, (const bf16_t*)(ws + OFF_W1 + W_DN1), FF}; pg8::Order S; S.init(NMT - 1, 8, G, bx, 0);
      pg8::EpiRes E{p.out, hmeta, p.out, (float*)nullptr, (bf16_t*)nullptr, (float*)nullptr}; tail_rows(lds, g.A, g.Bt, g.K, E, wv); pg8::gemm_phase(lds, g, S, E, wv); }
}

extern "C" void kernel_launch(void* const* d_in, const int* in_sizes, int n_in, void* d_out, int out_size, void* d_ws, size_t ws_size, hipStream_t stream) {
    static int grid_blocks = 0;
    if (grid_blocks == 0) {
        if (n_in != 20 || ws_size < WS_NEED) { fprintf(stderr, "kernel_launch: need 20 inputs and %zu bytes of workspace (got %d, %zu)\n", (size_t)WS_NEED, n_in, ws_size); grid_blocks = -1; return; }
        int dev = 0, cus = 0, per_cu = 0;
        hipGetDevice(&dev);
        hipDeviceGetAttribute(&cus, hipDeviceAttributeMultiprocessorCount, dev);
        if (hipFuncSetAttribute((const void*)fwd_megakernel, hipFuncAttributeMaxDynamicSharedMemorySize, LDS_BYTES) != hipSuccess) { fprintf(stderr, "kernel_launch: hipFuncSetAttribute failed\n"); }
        hipOccupancyMaxActiveBlocksPerMultiprocessor(&per_cu, (const void*)fwd_megakernel, 512, LDS_BYTES);
        if (per_cu < 1) { fprintf(stderr, "kernel_launch: occupancy query returned %d\n", per_cu); per_cu = 1; }
        (void)hipGetLastError();
        grid_blocks = cus * per_cu;
    }
    if (grid_blocks < 0) return;
    hipMemsetAsync((char*)d_ws + OFF_CTL, 0, CTL_BYTES, stream);
    Params p{};
    for (int i = 0; i < 20; ++i) p.in[i] = (const float*)d_in[i];
    p.out = (float*)d_out; p.ws = (unsigned char*)d_ws;
    void* args[] = {&p};
    hipError_t e = hipLaunchCooperativeKernel((const void*)fwd_megakernel, dim3(grid_blocks), dim3(512), args, LDS_BYTES, stream);
    if (e != hipSuccess) fprintf(stderr, "cooperative launch failed: %s (grid %d)\n", hipGetErrorString(e), grid_blocks);
}
```

```cpp
#include <hip/hip_runtime.h>
#include <hip/hip_cooperative_groups.h>
#include <cstdio>
#include <cstdint>
namespace cg = cooperative_groups;

#define LAS __attribute__((address_space(3)))
typedef unsigned short bf16_t;
typedef short bf16x8 __attribute__((ext_vector_type(8)));
typedef float f32x4 __attribute__((ext_vector_type(4)));
typedef unsigned u32x4 __attribute__((ext_vector_type(4)));
typedef unsigned u32x2 __attribute__((ext_vector_type(2)));

constexpr int NB = 2, T = 16400, SEQ = 16384, DM = 2048, M = NB * T, MPAD = 33024, NMT = 129;
constexpr int NAT0 = 5376, NAT1 = 6400, FF = 5632, FF2 = 11264;
constexpr int C_QNA = 0, C_KNA = 1024, C_QML = 2048, C_KML = 2560, C_VML = 3072, C_OML = 4096, C_GML = 5120;
constexpr int C_GQ = 0, C_GK = 1024, C_GV = 2048, C_GR = 4096, C_GLR = 6144;
constexpr float EPS = 1e-6f;
constexpr float LOG2E = 1.4426950408889634f;

constexpr size_t MiB = 1u << 20;
constexpr size_t OFF_CTL = 0, CTL_BYTES = 1 * MiB;
constexpr size_t OFF_SSQ = 64 * 1024;
constexpr size_t OFF_HMETA = 1 * MiB;
constexpr size_t OFF_ELAST = 2 * MiB;
constexpr size_t OFF_W1 = 8 * MiB;
constexpr size_t W_NAT1 = 0, W_OUT1 = (size_t)NAT1 * 4096, W_UP1 = W_OUT1 + 8 * MiB, W_DN1 = W_UP1 + 44 * MiB, W1_BYTES = W_DN1 + 22 * MiB;
constexpr size_t OFF_HB = 112 * MiB;
constexpr size_t OFF_NAT = 242 * MiB;
constexpr size_t OFF_MIX = 646 * MiB;
constexpr size_t OFF_W0 = 775 * MiB;
constexpr size_t W_NAT0 = 0, W_TR0 = 21 * MiB, W_OUT0 = 25 * MiB, W_UP0 = 33 * MiB, W_DN0 = 77 * MiB;
constexpr size_t OFF_TR = 874 * MiB;
constexpr size_t WS_NEED = 1000 * MiB;
static_assert(OFF_W1 + W1_BYTES <= OFF_HB, "map");
static_assert(OFF_HB + (size_t)(MPAD + 256) * 4096 <= OFF_NAT, "map");
static_assert(OFF_NAT + (size_t)MPAD * NAT1 * 2 <= OFF_MIX, "map");
static_assert(OFF_MIX + (size_t)MPAD * 4096 <= OFF_W0, "map");
static_assert(OFF_W0 + 99 * MiB <= OFF_TR && OFF_TR + (size_t)1024 * MPAD * 2 <= WS_NEED, "map");
static_assert(OFF_W0 + (size_t)MPAD * 4096 <= WS_NEED, "map");
static_assert((size_t)NAT0 * 4096 <= 21 * MiB, "map");

constexpr int LDS_BYTES = 147456;
constexpr int LDS_XCH = 131072;

struct Params { const float* in[20]; float* out; unsigned char* ws; };

__device__ __forceinline__ unsigned f2bf(float f) { unsigned u = __builtin_bit_cast(unsigned, f); return (u + 0x7fffu + ((u >> 16) & 1u)) >> 16; }
typedef float f32x2_pk __attribute__((ext_vector_type(2))); typedef __bf16 bf16x2_pk __attribute__((ext_vector_type(2)));
__device__ __forceinline__ unsigned pk2(float lo, float hi) { f32x2_pk v = {lo, hi}; bf16x2_pk b = __builtin_convertvector(v, bf16x2_pk); return __builtin_bit_cast(unsigned, b); }
__device__ __forceinline__ float bflo(unsigned u) { return __builtin_bit_cast(float, u << 16); }
__device__ __forceinline__ float bfhi(unsigned u) { return __builtin_bit_cast(float, u & 0xffff0000u); }
__device__ __forceinline__ float bf1(bf16_t v) { return __builtin_bit_cast(float, ((unsigned)v) << 16); }
__device__ __forceinline__ int lane_id_v() { int l; asm volatile("v_mbcnt_lo_u32_b32 %0, -1, 0\n\tv_mbcnt_hi_u32_b32 %0, -1, %0" : "=v"(l)); return l; }
__device__ __forceinline__ float sxor(float v, int m) { const int l = lane_id_v(); return __builtin_bit_cast(float, __builtin_amdgcn_ds_bpermute((l ^ m) << 2, __builtin_bit_cast(int, v))); }
__device__ __forceinline__ float sup(float v, int o) { const int l = lane_id_v(); return __builtin_bit_cast(float, __builtin_amdgcn_ds_bpermute(((l - o) & 63) << 2, __builtin_bit_cast(int, v))); }
__device__ __forceinline__ float sdown(float v, int o) { const int l = lane_id_v(); return __builtin_bit_cast(float, __builtin_amdgcn_ds_bpermute(((l + o) & 63) << 2, __builtin_bit_cast(int, v))); }
__device__ __forceinline__ float wave_sum(float v) {
#pragma unroll
    for (int o = 1; o < 64; o <<= 1) v += sxor(v, o);
    return v;
}
#define LDS_WAIT() asm volatile("s_waitcnt lgkmcnt(0)" ::: "memory")
#define BAR_LDS() do { asm volatile("s_waitcnt lgkmcnt(0)" ::: "memory"); __builtin_amdgcn_s_barrier(); asm volatile("" ::: "memory"); } while (0)
__device__ __forceinline__ int lane_id_v();
__device__ __forceinline__ int phase_tid(int wv) { return wv * 64 + lane_id_v(); }
__device__ __forceinline__ f32x4 mfma16(bf16x8 a, bf16x8 b, f32x4 c) { return __builtin_amdgcn_mfma_f32_16x16x32_bf16(a, b, c, 0, 0, 0); }
__device__ __forceinline__ float log_sigmoid(float x) { return fminf(x, 0.f) - __logf(1.0f + __expf(-fabsf(x))); }

namespace pg8 {
constexpr int BM = 256, BK = 64, HALF = 128, HTB = HALF * BK * 2, STAGE_BYTES = 8 * HTB, NXCD = 8, WGM = 4;
__host__ __device__ __forceinline__ int lds_byte(int r, int c) { const int st = (r >> 4) * 2 + (c >> 5), rr = r & 15, cc = c & 31, ob = rr * 64 + cc * 2; return st * 1024 + (ob ^ (((ob >> 9) & 1) << 5)); }
__host__ __device__ __forceinline__ void stage_rc(int b, int& R, int& C) { const int st = b / 1024, sb = b % 1024, swz = sb ^ (((sb >> 9) & 1) << 5); R = (st >> 1) * 16 + swz / 64; C = (st & 1) * 32 + (swz % 64) / 2; }
__host__ __device__ __forceinline__ int perm32(int rho) { const int n = rho >> 4, i = rho & 15; return 8 * (i >> 2) + 4 * n + (i & 3); }

struct Unit { int pm, pn; };
struct Gemm { const bf16_t* A; const bf16_t* Bt; int K; };

struct Order {
    int nM, nN, nwg, G, c, mode;
    __device__ void init(int nM_, int nN_, int G_, int c_, int mode_) { nM = nM_; nN = nN_; nwg = nM * nN; G = G_; c = c_; mode = mode_; }
    __device__ bool next(int i, Unit& u) const {
        const long L = (long)i * G + c; if (L >= nwg) return false;
        int wgid = (int)L; { const int q = nwg / NXCD, r = nwg % NXCD, xcd = wgid % NXCD, off = wgid / NXCD; wgid = (xcd < r ? xcd * (q + 1) : r * (q + 1) + (xcd - r) * q) + off; }
        const int nig = WGM * nN, gid = wgid / nig, fm = gid * WGM, gsz = (nM - fm) < WGM ? (nM - fm) : WGM;
        u.pm = fm + ((wgid % nig) % gsz); u.pn = (wgid % nig) / gsz; return true;
    }
    __device__ __forceinline__ long arow(const Unit& u) const { return mode ? (long)(u.pm / 65) * T + (long)(u.pm % 65) * 254 - 1 : (long)u.pm * 256; }
};

typedef float f32x2_t __attribute__((ext_vector_type(2))); typedef __bf16 bf16x2_t __attribute__((ext_vector_type(2)));
__device__ __forceinline__ unsigned cvt_pk_bf16(float lo, float hi) { f32x2_t v = {lo, hi}; bf16x2_t b = __builtin_convertvector(v, bf16x2_t); return __builtin_bit_cast(unsigned, b); }

struct EpiScale {
    static constexpr bool PERM = true;
    bf16_t* O; int ldc; const float* ssq;
    __device__ __forceinline__ void operator()(f32x4 (&acc)[2][2][4][2], const Unit& u, int wr, int wc, int fr, int fq) const {
#pragma unroll
        for (int ai = 0; ai < 2; ++ai)
#pragma unroll
            for (int m = 0; m < 4; ++m) {
                const int g = u.pm * BM + ai * HALF + wr * 64 + m * 16 + fr; const bool ok = g < M;
                const float rs = ok ? rsqrtf(ssq[g] * (1.0f / DM) + EPS) : 0.f;
                bf16_t* rowp = O + (size_t)g * ldc + u.pn * BM + wc * 32 + 8 * fq;
#pragma unroll
                for (int bj = 0; bj < 2; ++bj) {
                    f32x4 v0 = acc[ai][bj][m][0], v1 = acc[ai][bj][m][1]; u32x4 w;
                    if (ok) { w.x = cvt_pk_bf16(v0[0] * rs, v0[1] * rs); w.y = cvt_pk_bf16(v0[2] * rs, v0[3] * rs); w.z = cvt_pk_bf16(v1[0] * rs, v1[1] * rs); w.w = cvt_pk_bf16(v1[2] * rs, v1[3] * rs); }
                    else { w = (u32x4){0u, 0u, 0u, 0u}; }
                    *(u32x4*)(rowp + bj * HALF) = w;
                }
            }
    }
};
struct EpiScaleT {
    static constexpr bool PERM = true;
    bf16_t* O; const float* ssq;
    __device__ __forceinline__ void operator()(f32x4 (&acc)[2][2][4][2], const Unit& u, int wr, int wc, int fr, int fq) const {
        f32x4 rs[2][2];
#pragma unroll
        for (int bj = 0; bj < 2; ++bj)
#pragma unroll
            for (int n = 0; n < 2; ++n) { const int tk = u.pn * BM + bj * HALF + wc * 32 + 8 * fq + 4 * n;
#pragma unroll
                for (int e = 0; e < 4; ++e) rs[bj][n][e] = (tk + e) < M ? rsqrtf(ssq[tk + e] * (1.0f / DM) + EPS) : 0.f; }
#pragma unroll
        for (int ai = 0; ai < 2; ++ai)
#pragma unroll
            for (int m = 0; m < 4; ++m) {
                const int g = u.pm * BM + ai * HALF + wr * 64 + m * 16 + fr;
                bf16_t* rowp = O + (size_t)g * MPAD + u.pn * BM + wc * 32 + 8 * fq;
#pragma unroll
                for (int bj = 0; bj < 2; ++bj) {
                    f32x4 v0 = acc[ai][bj][m][0], v1 = acc[ai][bj][m][1]; u32x4 w;
#pragma unroll
                    for (int e = 0; e < 4; ++e) { v0[e] = rs[bj][0][e] != 0.f ? v0[e] * rs[bj][0][e] : 0.f; v1[e] = rs[bj][1][e] != 0.f ? v1[e] * rs[bj][1][e] : 0.f; }
                    w.x = cvt_pk_bf16(v0[0], v0[1]); w.y = cvt_pk_bf16(v0[2], v0[3]); w.z = cvt_pk_bf16(v1[0], v1[1]); w.w = cvt_pk_bf16(v1[2], v1[3]);
                    *(u32x4*)(rowp + bj * HALF) = w;
                }
            }
    }
};
struct EpiRes {
    static constexpr bool PERM = true;
    const float* srcx; const float* srcm; float* dstx; float* dstm; bf16_t* hb; float* ssq;
    __device__ __forceinline__ void operator()(f32x4 (&acc)[2][2][4][2], const Unit& u, int wr, int wc, int fr, int fq) const {
#pragma unroll
        for (int ai = 0; ai < 2; ++ai)
#pragma unroll
            for (int m = 0; m < 4; ++m) {
                const int g = u.pm * BM + ai * HALF + wr * 64 + m * 16 + fr; float ss = 0.f;
                if (g < M) {
                    const int b = g >= T ? 1 : 0, t = g - b * T;
                    const float* sp = t < 16 ? srcm + (size_t)(b * 16 + t) * DM : srcx + ((size_t)b * SEQ + (t - 16)) * DM;
                    float* dp = t < 16 ? (dstm ? dstm + (size_t)(b * 16 + t) * DM : (float*)nullptr) : dstx + ((size_t)b * SEQ + (t - 16)) * DM;
                    const int col0 = u.pn * BM + wc * 32 + 8 * fq;
#pragma unroll
                    for (int bj = 0; bj < 2; ++bj) {
                        const int col = col0 + bj * HALF;
                        const f32x4 v0 = *(const f32x4*)(sp + col) + acc[ai][bj][m][0], v1 = *(const f32x4*)(sp + col + 4) + acc[ai][bj][m][1];
                        if (dp) { *(f32x4*)(dp + col) = v0; *(f32x4*)(dp + col + 4) = v1; }
                        if (hb) { u32x4 w; w.x = cvt_pk_bf16(v0[0], v0[1]); w.y = cvt_pk_bf16(v0[2], v0[3]); w.z = cvt_pk_bf16(v1[0], v1[1]); w.w = cvt_pk_bf16(v1[2], v1[3]); *(u32x4*)(hb + (size_t)g * DM + col) = w; }
                        ss += (v0[0] * v0[0] + v0[1] * v0[1]) + (v0[2] * v0[2] + v0[3] * v0[3]) + (v1[0] * v1[0] + v1[1] * v1[1]) + (v1[2] * v1[2] + v1[3] * v1[3]);
                    }
                }
                ss += sxor(ss, 16); ss += sxor(ss, 32);
                if (ssq && fq == 0 && g < M) atomicAdd(ssq + g, ss);
            }
    }
};
__device__ __forceinline__ float dppf(float old, float src, const int ctrl_sel) {
    int r;
    if (ctrl_sel == 0) r = __builtin_amdgcn_mov_dpp(__builtin_bit_cast(int, src), 0x121, 0xf, 0xf, true);
    else if (ctrl_sel == 1) r = __builtin_amdgcn_update_dpp(__builtin_bit_cast(int, old), __builtin_bit_cast(int, src), 0x111, 0xf, 0xf, false);
    else if (ctrl_sel == 2) r = __builtin_amdgcn_mov_dpp(__builtin_bit_cast(int, src), 0x12f, 0xf, 0xf, true);
    else r = __builtin_amdgcn_update_dpp(__builtin_bit_cast(int, old), __builtin_bit_cast(int, src), 0x101, 0xf, 0xf, false);
    return __builtin_bit_cast(float, r);
}
struct EpiFfn {
    static constexpr bool PERM = true;
    bf16_t* act; const float* ssq; const float* cw; const float* cb; LAS float* xl;
    __device__ __forceinline__ void operator()(f32x4 (&acc)[2][2][4][2], const Unit& u, int wr, int wc, int fr_in, int fq_in) const {
        int lane_e; asm volatile("v_mbcnt_lo_u32_b32 %0, -1, 0\n\tv_mbcnt_hi_u32_b32 %0, -1, %0" : "=v"(lane_e));
        int fr = lane_e & 15, fq = lane_e >> 4; (void)fr_in; (void)fq_in;
        const int b = u.pm / 65, jt = u.pm % 65, tb = jt * 254 - 1;
#pragma unroll
        for (int ai = 0; ai < 2; ++ai)
#pragma unroll
            for (int m = 0; m < 4; ++m) {
                const int t = tb + ai * HALF + wr * 64 + m * 16 + fr; const bool ok = (t >= 0) && (t < T);
                const float rs = ok ? rsqrtf(ssq[b * T + (ok ? t : 0)] * (1.0f / DM) + EPS) : 0.f;
#pragma unroll
                for (int bj = 0; bj < 2; ++bj)
#pragma unroll
                    for (int n = 0; n < 2; ++n)
#pragma unroll
                        for (int e = 0; e < 4; ++e) acc[ai][bj][m][n][e] = acc[ai][bj][m][n][e] * rs;
            }
        asm volatile("" : "+v"(fr), "+v"(fq));
#pragma unroll
        for (int ai = 0; ai < 2; ++ai) { const int blk = 2 * ai + wr;
#pragma unroll
            for (int bj = 0; bj < 2; ++bj)
#pragma unroll
                for (int n = 0; n < 2; ++n) {
                    if (fr == 0)  *(LAS f32x4*)(xl + ((((blk * 2 + 0) * 4 + wc) * 2 + bj) * 32 + 8 * fq + 4 * n)) = acc[ai][bj][0][n];
                    if (fr == 15) *(LAS f32x4*)(xl + ((((blk * 2 + 1) * 4 + wc) * 2 + bj) * 32 + 8 * fq + 4 * n)) = acc[ai][bj][3][n];
                } }
        LAS float* pl = xl + 2048;
        { const int tix = (wr * 4 + wc) * 64 + (fq * 16 + fr);
#pragma unroll
          for (int i = 0; i < 2; ++i) { const int id = tix + 512 * i, k = id >> 8, tc = id & 255; const int ch = (tc < 128 ? 0 : FF) + u.pn * HALF + (tc & 127);
              pl[id] = k < 3 ? cw[k * FF2 + ch] : cb[ch]; } }
        LDS_WAIT(); __builtin_amdgcn_s_barrier(); asm volatile("" ::: "memory");
        asm volatile("" : "+v"(fr), "+v"(fq));
        LAS float* pb = pl + wc * 32 + 8 * fq; asm volatile("" : "+v"(pb));
        LAS float* xb = xl + 512 + wr * 512 + wc * 64 + 8 * fq - 512 - 512; asm volatile("" : "+v"(xb));
#pragma unroll
        for (int ai = 0; ai < 2; ++ai) { const int blk = 2 * ai + wr;
#pragma unroll
            for (int m = 0; m < 4; ++m) {
                const int r = ai * HALF + wr * 64 + m * 16 + fr, t = tb + r;
                float o[8];
#pragma unroll
                for (int n = 0; n < 2; ++n) {
                    f32x4 y[2];
#pragma unroll
                    for (int bj = 0; bj < 2; ++bj) {
                        const int pc = bj * 128 + 4 * n;
                        const f32x4 w0 = *(LAS const f32x4*)(pb + pc), w1 = *(LAS const f32x4*)(pb + 256 + pc), w2 = *(LAS const f32x4*)(pb + 512 + pc), bb = *(LAS const f32x4*)(pb + 768 + pc);
                        f32x4 ps, ns;
                        if (m > 0) ps = acc[ai][bj][m > 0 ? m - 1 : 0][n];
                        else ps = blk > 0 ? *(LAS const f32x4*)(xb + (ai * 1024 + 256 + bj * 32 + 4 * n)) : (f32x4){0.f, 0.f, 0.f, 0.f};
                        if (m < 3) ns = acc[ai][bj][m < 3 ? m + 1 : 3][n];
                        else ns = blk < 3 ? *(LAS const f32x4*)(xb + (ai * 1024 + 1024 + bj * 32 + 4 * n)) : (f32x4){0.f, 0.f, 0.f, 0.f};
                        const f32x4 cur = acc[ai][bj][m][n];
#pragma unroll
                        for (int e = 0; e < 4; ++e) {
                            const float t1 = m > 0 ? dppf(0.f, ps[e], 0) : ps[e];
                            const float pv = dppf(t1, cur[e], 1);
                            const float t2 = m < 3 ? dppf(0.f, ns[e], 2) : ns[e];
                            const float nx = dppf(t2, cur[e], 3);
                            y[bj][e] = bb[e] + w0[e] * pv + w1[e] * cur[e] + w2[e] * nx;
                        }
                        __builtin_amdgcn_sched_barrier(0);
                    }
#pragma unroll
                    for (int e = 0; e < 4; ++e) { const float g = y[0][e]; o[4 * n + e] = g * y[1][e] * __builtin_amdgcn_rcpf(1.0f + __expf(-g)); }
                }
                if (r >= 1 && r < 255 && t < T) {
                    u32x4 w; w.x = cvt_pk_bf16(o[0], o[1]); w.y = cvt_pk_bf16(o[2], o[3]); w.z = cvt_pk_bf16(o[4], o[5]); w.w = cvt_pk_bf16(o[6], o[7]);
                    *(u32x4*)(act + (size_t)(b * T + t) * FF + u.pn * HALF + wc * 32 + 8 * fq) = w;
                }
                __builtin_amdgcn_sched_barrier(0);
            }
        }
    }
};

template <class Epi>
__device__ __forceinline__ void gemm_phase(LAS unsigned char* lds, const Gemm g, const Order& S, const Epi& E, int wv) {
    const int tid = phase_tid(wv), wid = __builtin_amdgcn_readfirstlane(tid >> 6), lane = tid & 63, wr = wid >> 2, wc = wid & 3, fr = lane & 15, fq = lane >> 4;
    const int K = g.K, nt = K / BK;
    unsigned voffA[2], voffB[2];
#pragma unroll
    for (int i = 0; i < 2; ++i) { int R, C; stage_rc(tid * 16 + i * 8192, R, C); const int Rb = Epi::PERM ? ((R & ~31) + perm32(R & 31)) : R;
        voffA[i] = (unsigned)(R * K + C) * 2u; voffB[i] = (unsigned)(Rb * K + C) * 2u; }
    const size_t kstep = (size_t)(BK * 2);
    const size_t hstep = (size_t)HALF * K * 2;
    const size_t tstep = 2 * hstep;
    const long rowb = (long)K * 2;
    const unsigned ldsw = (unsigned)wid * 1024u;
    const int aoff = lds_byte(wr * 64 + fr, fq * 8), boff = lds_byte(wc * 32 + fr, fq * 8);
#define PG8_SA(b, h) (((b) * 2 + (h)) * HTB)
#define PG8_SB(b, h) ((4 + (b) * 2 + (h)) * HTB)
#define PG8_STAGE(bufoff, gbase, voff) do { _Pragma("unroll") for (int _i = 0; _i < 2; ++_i) \
        __builtin_amdgcn_global_load_lds((const unsigned*)((const char*)(gbase) + (voff)[_i]), (LAS unsigned*)(lds + (bufoff) + ldsw + _i * 8192), 16, 0, 0); } while (0)
#define PG8_LDA(dst, b, h) do { _Pragma("unroll") for (int m = 0; m < 4; ++m) _Pragma("unroll") for (int k = 0; k < 2; ++k) dst[m][k] = *(const LAS bf16x8*)(lds + PG8_SA(b, h) + aoff + m * 2048 + k * 1024); } while (0)
#define PG8_LDB(dst, b, h) do { _Pragma("unroll") for (int n = 0; n < 2; ++n) _Pragma("unroll") for (int k = 0; k < 2; ++k) dst[n][k] = *(const LAS bf16x8*)(lds + PG8_SB(b, h) + boff + n * 2048 + k * 1024); } while (0)
#define PG8_MMA(ai, bj, At, Bt) do { __builtin_amdgcn_s_setprio(1); _Pragma("unroll") for (int m = 0; m < 4; ++m) _Pragma("unroll") for (int n = 0; n < 2; ++n) _Pragma("unroll") for (int k = 0; k < 2; ++k) \
        acc[ai][bj][m][n] = __builtin_amdgcn_mfma_f32_16x16x32_bf16(Bt[n][k], At[m][k], acc[ai][bj][m][n], 0, 0, 0); __builtin_amdgcn_s_setprio(0); } while (0)
#define PG8_WAIT_V(n) asm volatile("s_waitcnt vmcnt(" #n ")" ::: "memory")
#define PG8_WAIT_L(n) asm volatile("s_waitcnt lgkmcnt(" #n ")" ::: "memory")
#define PG8_BAR __builtin_amdgcn_s_barrier()
#define PG8_SCHED __builtin_amdgcn_sched_barrier(0)
    Unit cur, nxt; int ui = 0;
    if (!S.next(0, cur)) return;
    f32x4 acc[2][2][4][2];
#pragma unroll
    for (int a = 0; a < 2; ++a)
#pragma unroll
        for (int b = 0; b < 2; ++b)
#pragma unroll
            for (int m = 0; m < 4; ++m)
#pragma unroll
                for (int n = 0; n < 2; ++n) acc[a][b][m][n] = (f32x4){0.f, 0.f, 0.f, 0.f};
    bf16x8 At[4][2], B0[2][2], B1[2][2];
    const char* cA = (const char*)g.A + S.arow(cur) * rowb; const char* cB = (const char*)g.Bt + (size_t)cur.pn * tstep;
    PG8_STAGE(PG8_SB(0, 0), cB, voffB); PG8_STAGE(PG8_SB(0, 1), cB + hstep, voffB); PG8_STAGE(PG8_SA(0, 0), cA, voffA); PG8_STAGE(PG8_SA(0, 1), cA + hstep, voffA);
    if (wr == 1) PG8_BAR;
    PG8_WAIT_V(2); PG8_BAR;
    PG8_STAGE(PG8_SB(1, 0), cB + kstep, voffB); PG8_STAGE(PG8_SA(1, 0), cA + kstep, voffA); PG8_STAGE(PG8_SB(1, 1), cB + hstep + kstep, voffB);
    PG8_WAIT_V(6); PG8_BAR;
    for (;;) {
        const bool has_next = S.next(ui + 1, nxt);
        const char* nA = has_next ? (const char*)g.A + S.arow(nxt) * rowb : cA; const char* nB = has_next ? (const char*)g.Bt + (size_t)nxt.pn * tstep : cB;
        for (int t = 0; t < nt; t += 2) {
            const bool last = (t == nt - 2);
            const char* a1 = cA + (size_t)(t + 1) * kstep;
            const char* a2 = last ? nA : cA + (size_t)(t + 2) * kstep; const char* b2 = last ? nB : cB + (size_t)(t + 2) * kstep;
            const char* a3 = a2 + kstep; const char* b3 = b2 + kstep;
            PG8_LDB(B0, 0, 0); PG8_LDB(B1, 0, 1); PG8_SCHED; PG8_LDA(At, 0, 0); PG8_STAGE(PG8_SA(1, 1), a1 + hstep, voffA);
            PG8_WAIT_V(8); PG8_WAIT_L(0); PG8_BAR; PG8_MMA(0, 0, At, B0); PG8_MMA(0, 1, At, B1); PG8_BAR; PG8_SCHED;
            PG8_LDA(At, 0, 1); PG8_STAGE(PG8_SB(0, 0), b2, voffB); PG8_STAGE(PG8_SB(0, 1), b2 + hstep, voffB); PG8_STAGE(PG8_SA(0, 0), a2, voffA);
            PG8_WAIT_V(8); PG8_WAIT_L(0); PG8_BAR; PG8_MMA(1, 0, At, B0); PG8_MMA(1, 1, At, B1); PG8_BAR; PG8_SCHED;
            PG8_LDB(B0, 1, 0); PG8_LDB(B1, 1, 1); PG8_SCHED; PG8_LDA(At, 1, 0); PG8_STAGE(PG8_SA(0, 1), a2 + hstep, voffA);
            PG8_WAIT_V(8); PG8_WAIT_L(0); PG8_BAR; PG8_MMA(0, 0, At, B0); PG8_MMA(0, 1, At, B1); PG8_BAR; PG8_SCHED;
            PG8_LDA(At, 1, 1); PG8_STAGE(PG8_SB(1, 0), b3, voffB); PG8_STAGE(PG8_SB(1, 1), b3 + hstep, voffB); PG8_STAGE(PG8_SA(1, 0), a3, voffA);
            PG8_WAIT_V(8); PG8_WAIT_L(0); PG8_BAR; PG8_MMA(1, 0, At, B0); PG8_MMA(1, 1, At, B1); PG8_BAR; PG8_SCHED;
        }
        if (wr == 0) PG8_BAR;
        E(acc, cur, wr, wc, fr, fq);
        if (!has_next) break;
#pragma unroll
        for (int a = 0; a < 2; ++a)
#pragma unroll
            for (int b = 0; b < 2; ++b)
#pragma unroll
                for (int m = 0; m < 4; ++m)
#pragma unroll
                    for (int n = 0; n < 2; ++n) acc[a][b][m][n] = (f32x4){0.f, 0.f, 0.f, 0.f};
        cur = nxt; cA = nA; cB = nB; ++ui;
        if (wr == 1) PG8_BAR;
    }
    PG8_WAIT_V(0);
    PG8_BAR;
#undef PG8_SA
#undef PG8_SB
#undef PG8_STAGE
#undef PG8_LDA
#undef PG8_LDB
#undef PG8_MMA
#undef PG8_WAIT_V
#undef PG8_WAIT_L
#undef PG8_BAR
#undef PG8_SCHED
}
}

struct Job { const float* W; int K, ldw, c0, nc; bf16_t* dst; int ldd; const float* gain; float cs; int mode; };
__device__ __forceinline__ int ffnrow(int c) { return c < FF ? 256 * (c >> 7) + (c & 127) : 256 * ((c - FF) >> 7) + 128 + ((c - FF) & 127); }
__device__ __forceinline__ void conv_item(const Job& J, int item, LAS float* scr, int lane) {
    const int nblk = (J.nc + 63) >> 6, kb = item / nblk, nb = item % nblk, k0 = 64 * kb, n0 = 64 * nb;
    const int c4 = 4 * (lane & 15), kr = lane >> 4; const bool cv = (n0 + c4) < J.nc;
#pragma unroll
    for (int hb_ = 0; hb_ < 2; ++hb_) {
        f32x4 v[8];
#pragma unroll
        for (int i = 0; i < 8; ++i) { const int kk = 32 * hb_ + 4 * i + kr;
            v[i] = cv ? *(const f32x4*)(J.W + (size_t)(k0 + kk) * J.ldw + J.c0 + n0 + c4) : (f32x4){0.f, 0.f, 0.f, 0.f}; }
#pragma unroll
        for (int i = 0; i < 8; ++i) { const int kk = 32 * hb_ + 4 * i + kr; const float gm = (J.gain ? J.gain[k0 + kk] : 1.0f) * J.cs;
            LAS float* s = scr + kk * 65 + c4; s[0] = v[i][0] * gm; s[1] = v[i][1] * gm; s[2] = v[i][2] * gm; s[3] = v[i][3] * gm; }
    }
    LDS_WAIT(); asm volatile("" ::: "memory");
    const int c = lane & 7;
#pragma unroll
    for (int j = 0; j < 8; ++j) { const int n = (lane >> 3) + 8 * j; const LAS float* s = scr + (8 * c) * 65 + n;
        u32x4 o; o.x = pk2(s[0 * 65], s[1 * 65]); o.y = pk2(s[2 * 65], s[3 * 65]); o.z = pk2(s[4 * 65], s[5 * 65]); o.w = pk2(s[6 * 65], s[7 * 65]);
        if (n0 + n < J.nc) { const int drow = J.mode ? ffnrow(J.c0 + n0 + n) : (n0 + n);
            *(u32x4*)(J.dst + (size_t)drow * J.ldd + k0 + 8 * c) = o; } }
    LDS_WAIT(); asm volatile("" ::: "memory");
}
__device__ __forceinline__ Job get_job(const Params& p, int j) {
    unsigned char* ws = p.ws;
    bf16_t* natw0 = (bf16_t*)(ws + OFF_W0 + W_NAT0); bf16_t* trw0 = (bf16_t*)(ws + OFF_W0 + W_TR0);
    bf16_t* natw1 = (bf16_t*)(ws + OFF_W1 + W_NAT1);
    Job J; J.gain = nullptr; J.cs = 1.f; J.mode = 0; J.K = DM; J.ldd = DM;
    switch (j) {
    case 0: J.W = p.in[4]; J.ldw = 6160; J.c0 = 0; J.nc = 2048; J.dst = natw0; J.gain = p.in[2]; break;
    case 1: J.W = p.in[4]; J.ldw = 6160; J.c0 = 2048; J.nc = 1024; J.dst = trw0; J.gain = p.in[2]; break;
    case 2: J.W = p.in[4]; J.ldw = 6160; J.c0 = 3072; J.nc = 512; J.dst = natw0 + (size_t)C_QML * DM; J.gain = p.in[2]; break;
    case 3: J.W = p.in[4]; J.ldw = 6160; J.c0 = 3584; J.nc = 512; J.dst = natw0 + (size_t)C_KML * DM; J.gain = p.in[2]; J.cs = 0.08838834764831845f; break;
    case 4: J.W = p.in[4]; J.ldw = 6160; J.c0 = 4096; J.nc = 2048; J.dst = natw0 + (size_t)C_VML * DM; J.gain = p.in[2]; break;
    case 5: J.W = p.in[4]; J.ldw = 6160; J.c0 = 6144; J.nc = 16; J.dst = natw0 + (size_t)C_GML * DM; J.gain = p.in[2]; break;
    case 6: J.W = p.in[10]; J.ldw = 2048; J.c0 = 0; J.nc = 2048; J.dst = (bf16_t*)(ws + OFF_W0 + W_OUT0); break;
    case 7: J.W = p.in[16]; J.ldw = FF2; J.c0 = 0; J.nc = FF2; J.dst = (bf16_t*)(ws + OFF_W0 + W_UP0); J.gain = p.in[3]; J.mode = 1; break;
    case 8: J.W = p.in[19]; J.K = FF; J.ldw = 2048; J.c0 = 0; J.nc = 2048; J.dst = (bf16_t*)(ws + OFF_W0 + W_DN0); J.ldd = FF; break;
    case 9: J.W = p.in[11]; J.ldw = 6176; J.c0 = 0; J.nc = 1024; J.dst = natw1; J.gain = p.in[2] + DM; J.cs = 0.0625f; break;
    case 10: J.W = p.in[11]; J.ldw = 6176; J.c0 = 1024; J.nc = 5120; J.dst = natw1 + (size_t)1024 * DM; J.gain = p.in[2] + DM; break;
    case 11: J.W = p.in[11]; J.ldw = 6176; J.c0 = 6144; J.nc = 32; J.dst = natw1 + (size_t)C_GLR * DM; J.gain = p.in[2] + DM; break;
    case 12: J.W = p.in[15]; J.ldw = 2048; J.c0 = 0; J.nc = 2048; J.dst = (bf16_t*)(ws + OFF_W1 + W_OUT1); break;
    case 13: J.W = p.in[16] + (size_t)DM * FF2; J.ldw = FF2; J.c0 = 0; J.nc = FF2; J.dst = (bf16_t*)(ws + OFF_W1 + W_UP1); J.gain = p.in[3] + DM; J.mode = 1; break;
    default: J.W = p.in[19] + (size_t)FF * DM; J.K = FF; J.ldw = 2048; J.c0 = 0; J.nc = 2048; J.dst = (bf16_t*)(ws + OFF_W1 + W_DN1); J.ldd = FF; break;
    }
    return J;
}
constexpr int NJOBS = 15;

__device__ __forceinline__ void p0_prologue(const Params& p, LAS unsigned char* lds, int wv) {
    const int tid = phase_tid(wv), lane = tid & 63, wave = tid >> 6;
    const int gw = blockIdx.x * 8 + wave, NGW = gridDim.x * 8;
    unsigned char* ws = p.ws;
    bf16_t* hb = (bf16_t*)(ws + OFF_HB) + (size_t)256 * DM;
    float* ssq0 = (float*)(ws + OFF_SSQ);
    float* hmeta = (float*)(ws + OFF_HMETA);
    for (int g = gw; g < M; g += NGW) {
        const int b = g >= T ? 1 : 0, t = g - b * T;
        const float* src = t < 16 ? p.in[1] + (size_t)t * DM : p.in[0] + ((size_t)b * SEQ + (t - 16)) * DM;
        float s = 0.f;
#pragma unroll
        for (int j = 0; j < 8; ++j) { const f32x4 v = *(const f32x4*)(src + 4 * lane + 256 * j);
            s += (v[0] * v[0] + v[1] * v[1]) + (v[2] * v[2] + v[3] * v[3]);
            u32x2 w; w.x = pk2(v[0], v[1]); w.y = pk2(v[2], v[3]); *(u32x2*)(hb + (size_t)g * DM + 4 * lane + 256 * j) = w;
            if (t < 16) *(f32x4*)(hmeta + (size_t)(b * 16 + t) * DM + 4 * lane + 256 * j) = v; }
        s = wave_sum(s);
        if (lane == 0) ssq0[g] = s;
    }
    for (int r = gw; r < 256 + (MPAD - M); r += NGW) { const long row = r < 256 ? (long)r - 256 : (long)M + (r - 256);
#pragma unroll
        for (int j = 0; j < 4; ++j) *(u32x4*)(hb + row * DM + 8 * lane + 512 * j) = (u32x4){0u, 0u, 0u, 0u}; }
    { bf16_t* natw0 = (bf16_t*)(ws + OFF_W0 + W_NAT0); bf16_t* natw1 = (bf16_t*)(ws + OFF_W1 + W_NAT1);
      const int z0 = NAT0 - 5136, z1 = NAT1 - 6176;
      for (int r = gw; r < z0 + z1; r += NGW) { bf16_t* rowp = r < z0 ? natw0 + (size_t)(5136 + r) * DM : natw1 + (size_t)(6176 + (r - z0)) * DM;
#pragma unroll
          for (int j = 0; j < 4; ++j) *(u32x4*)(rowp + 8 * lane + 512 * j) = (u32x4){0u, 0u, 0u, 0u}; } }
    LAS float* scr = (LAS float*)(lds + wave * 16640);
    constexpr int JI[NJOBS] = {1024, 512, 256, 256, 1024, 32, 1024, 5632, 2816, 512, 2560, 32, 1024, 5632, 2816};
    constexpr int JTOT = 1024 + 512 + 256 + 256 + 1024 + 32 + 1024 + 5632 + 2816 + 512 + 2560 + 32 + 1024 + 5632 + 2816;
    for (int it = gw; it < JTOT; it += NGW) {
        int j = 0, base = 0;
#pragma unroll
        for (int k = 0; k < NJOBS - 1; ++k) { if (it >= base + JI[k]) { base += JI[k]; j = k + 1; } else break; }
        const Job J = get_job(p, j);
        conv_item(J, it - base, scr, lane);
    }
}

__device__ __forceinline__ void qknorm_phase(const Params& p, int wv) {
    const int tid = phase_tid(wv), lane = tid & 63, wave = tid >> 6;
    const int gw = blockIdx.x * 8 + wave, NGW = gridDim.x * 8;
    bf16_t* nat = (bf16_t*)(p.ws + OFF_NAT);
    const float qs = 0.08838834764831845f * LOG2E;
    for (int g = gw; g < M; g += NGW) {
#pragma unroll
        for (int j = 0; j < 4; ++j) {
            const int col = 8 * lane + 512 * j;
            u32x4 v = *(const u32x4*)(nat + (size_t)g * NAT0 + col);
            float f[8] = {bflo(v.x), bfhi(v.x), bflo(v.y), bfhi(v.y), bflo(v.z), bfhi(v.z), bflo(v.w), bfhi(v.w)};
            float s = 0.f;
#pragma unroll
            for (int e = 0; e < 8; ++e) s += f[e] * f[e];
            s += sxor(s, 1); s += sxor(s, 2); s += sxor(s, 4); s += sxor(s, 8);
            const float rs = rsqrtf(s * (1.0f / 128.0f) + EPS);
            const bool isq = col < 1024; const float* gn = (isq ? p.in[6] : p.in[7]) + (col & 127);
            const float sc = isq ? rs * qs : rs;
#pragma unroll
            for (int e = 0; e < 8; ++e) f[e] = f[e] * sc * gn[e];
            v.x = pk2(f[0], f[1]); v.y = pk2(f[2], f[3]); v.z = pk2(f[4], f[5]); v.w = pk2(f[6], f[7]);
            *(u32x4*)(nat + (size_t)g * NAT0 + col) = v;
        }
    }
}

constexpr int NA_UNITS = NB * 256 * 4 * 8 + NB * 8;
#define NA_KLOAD(DST_, I_) do { const int tb_ = (I_) < 8 ? b * T + 16 + (r0 + (I_)) * 64 + cs : b * T; \
        _Pragma("unroll") for (int tau = 0; tau < 2; ++tau) { const bf16_t* kp_ = kbase + (size_t)(tb_ + 8 * (jq >> 2) + 4 * tau + (jq & 3)) * NAT0; \
            _Pragma("unroll") for (int kk = 0; kk < 4; ++kk) DST_[tau * 4 + kk] = *(const bf16x8*)(kp_ + 32 * kk); } } while (0)
#define NA_SCORE(SRC_, I_) do { \
        _Pragma("unroll") for (int tau = 0; tau < 2; ++tau) { f32x4 a_ = (f32x4){0.f, 0.f, 0.f, 0.f}; \
            _Pragma("unroll") for (int kk = 0; kk < 4; ++kk) a_ = mfma16(SRC_[tau * 4 + kk], qf[kk], a_); \
            _Pragma("unroll") for (int rho = 0; rho < 4; ++rho) { float s_; \
                if ((I_) < 8) { const int kc = cs + 8 * q + 4 * tau + rho; const bool ok = (kc >= c0) && (kc < c0 + 16); \
                    int dc = kc - qc + 15; dc = dc < 0 ? 0 : (dc > 30 ? 30 : dc); const int dr = r0 - r + (I_) + 7; \
                    s_ = ok ? a_[rho] + rb[dr * 31 + dc] : -INFINITY; } \
                else { s_ = (q < 2) ? a_[rho] : -INFINITY; } \
                a_[rho] = s_; mx = fmaxf(mx, s_); } \
            sc[I_][tau] = a_; } } while (0)
#define NA_VLOAD(DST_, I_) do { const int tb_ = (I_) < 8 ? b * T + 16 + (r0 + (I_)) * 64 + cs : b * T; \
        const bf16_t* vp_ = vt + (size_t)(h * 128 + jq) * MPAD + tb_ + 8 * q; \
        _Pragma("unroll") for (int dt = 0; dt < 8; ++dt) DST_[dt] = *(const bf16x8*)(vp_ + (size_t)(16 * dt) * MPAD); } while (0)
#define NA_PV(SRC_, I_) do { float pv_[8]; \
        _Pragma("unroll") for (int tau = 0; tau < 2; ++tau) \
            _Pragma("unroll") for (int rho = 0; rho < 4; ++rho) { const float e_ = __builtin_amdgcn_exp2f(sc[I_][tau][rho] - mx); pv_[4 * tau + rho] = e_; sum += e_; } \
        u32x4 pw_; pw_.x = pk2(pv_[0], pv_[1]); pw_.y = pk2(pv_[2], pv_[3]); pw_.z = pk2(pv_[4], pv_[5]); pw_.w = pk2(pv_[6], pv_[7]); \
        const bf16x8 pf_ = __builtin_bit_cast(bf16x8, pw_); \
        _Pragma("unroll") for (int dt = 0; dt < 8; ++dt) o[dt] = mfma16(SRC_[dt], pf_, o[dt]); } while (0)
__device__ __forceinline__ void na_unit(const Params& p, int id, int lane, const LAS float* rbt) {
    const bf16_t* nat = (const bf16_t*)(p.ws + OFF_NAT);
    const bf16_t* vt = (const bf16_t*)(p.ws + OFF_TR);
    bf16_t* mix = (bf16_t*)(p.ws + OFF_MIX);
    const int jq = lane & 15, q = lane >> 4;
    int b, h, r = 0, j = 0, r0 = 0, cs = 0, qtok; bool meta;
    if (id < NB * 256 * 4 * 8) { h = id & 7; j = (id >> 3) & 3; r = (id >> 5) & 255; b = id >> 13;
        r0 = r - 4; r0 = r0 < 0 ? 0 : (r0 > 248 ? 248 : r0); cs = 16 * j - 8; cs = cs < 0 ? 0 : (cs > 32 ? 32 : cs);
        qtok = b * T + 16 + r * 64 + 16 * j; meta = false; }
    else { const int m = id - NB * 256 * 4 * 8; h = m & 7; b = m >> 3; qtok = b * T; meta = true; }
    bf16x8 qf[4];
    { const bf16_t* qp = nat + (size_t)(qtok + jq) * NAT0 + C_QNA + h * 128 + 8 * q;
#pragma unroll
      for (int kk = 0; kk < 4; ++kk) qf[kk] = *(const bf16x8*)(qp + 32 * kk); }
    f32x4 sc[9][2];
    const bf16_t* kbase = nat + C_KNA + h * 128 + 8 * q;
    const LAS float* rb = rbt + h * (15 * 31);
    const int qc = 16 * j + jq; int c0 = qc - 8; c0 = c0 < 0 ? 0 : (c0 > 48 ? 48 : c0);
    float mx = -INFINITY, sum = 0.f;
    f32x4 o[8];
#pragma unroll
    for (int dt = 0; dt < 8; ++dt) o[dt] = (f32x4){0.f, 0.f, 0.f, 0.f};
    bf16x8 fa[8], fb[8];
    if (!meta) {
        NA_KLOAD(fa, 0);
        NA_KLOAD(fb, 1); NA_SCORE(fa, 0);
        NA_KLOAD(fa, 2); NA_SCORE(fb, 1);
        NA_KLOAD(fb, 3); NA_SCORE(fa, 2);
        NA_KLOAD(fa, 4); NA_SCORE(fb, 3);
        NA_KLOAD(fb, 5); NA_SCORE(fa, 4);
        NA_KLOAD(fa, 6); NA_SCORE(fb, 5);
        NA_KLOAD(fb, 7); NA_SCORE(fa, 6);
        NA_KLOAD(fa, 8); NA_SCORE(fb, 7);
        NA_VLOAD(fb, 0); NA_SCORE(fa, 8);
        mx = fmaxf(mx, sxor(mx, 16)); mx = fmaxf(mx, sxor(mx, 32));
        NA_VLOAD(fa, 1); NA_PV(fb, 0);
        NA_VLOAD(fb, 2); NA_PV(fa, 1);
        NA_VLOAD(fa, 3); NA_PV(fb, 2);
        NA_VLOAD(fb, 4); NA_PV(fa, 3);
        NA_VLOAD(fa, 5); NA_PV(fb, 4);
        NA_VLOAD(fb, 6); NA_PV(fa, 5);
        NA_VLOAD(fa, 7); NA_PV(fb, 6);
        NA_VLOAD(fb, 8); NA_PV(fa, 7);
        NA_PV(fb, 8);
    } else {
        NA_KLOAD(fa, 8); NA_VLOAD(fb, 8); NA_SCORE(fa, 8);
        mx = fmaxf(mx, sxor(mx, 16)); mx = fmaxf(mx, sxor(mx, 32));
        NA_PV(fb, 8);
    }
    sum += sxor(sum, 16); sum += sxor(sum, 32);
    const float inv = 1.0f / sum;
    bf16_t* op = mix + (size_t)(qtok + jq) * DM + h * 128 + 4 * q;
#pragma unroll
    for (int dt = 0; dt < 8; ++dt) { u32x2 w; w.x = pk2(o[dt][0] * inv, o[dt][1] * inv); w.y = pk2(o[dt][2] * inv, o[dt][3] * inv); *(u32x2*)(op + 16 * dt) = w; }
}
__device__ __forceinline__ void na_phase(const Params& p, LAS unsigned char* lds, unsigned* ctr, int wv) {
    const int tid = phase_tid(wv), lane = tid & 63;
    LAS float* rbt = (LAS float*)lds;
    __syncthreads();
    for (int i = tid; i < 8 * 15 * 31; i += 512) rbt[i] = p.in[8][i] * LOG2E;
    __syncthreads();
    for (;;) {
        int id = 0;
        if (lane == 0) id = (int)atomicAdd(ctr, 1u);
        id = __builtin_amdgcn_readfirstlane(id);
        if (id >= NA_UNITS) break;
        na_unit(p, id, lane, rbt);
    }
}

typedef short v4i16_t __attribute__((ext_vector_type(4)));
__device__ __forceinline__ bf16x8 gather8_tr(const LAS bf16_t* tile, int row0, int stride, int col0, int lane) {
    const int qq = (lane & 15) >> 2, pp = lane & 3;
    const LAS bf16_t* a0 = tile + (row0 + qq) * stride + col0 + 4 * pp;
    const v4i16_t lo = __builtin_amdgcn_ds_read_tr16_b64_v4i16((LAS v4i16_t*)a0);
    const v4i16_t hi = __builtin_amdgcn_ds_read_tr16_b64_v4i16((LAS v4i16_t*)(a0 + 4 * stride));
    return (bf16x8){lo[0], lo[1], lo[2], lo[3], hi[0], hi[1], hi[2], hi[3]};
}
__device__ __forceinline__ bf16x8 gather8(const LAS bf16_t* ptr, int stride) {
    bf16x8 r;
#pragma unroll
    for (int e = 0; e < 8; ++e) r[e] = (short)ptr[e * stride];
    return r;
}
constexpr size_t GA_STRIDE = (size_t)8 * MPAD;
constexpr size_t OFF_PT = OFF_TR + 65 * MiB;
static_assert(OFF_PT + (size_t)16 * 257 * 8192 <= 1000 * MiB, "map");
__device__ __forceinline__ void ml_pre(const Params& p, LAS unsigned char* lds, int wv) {
    const int tid = phase_tid(wv), lane = tid & 63, w = wv, jq = lane & 15, q = lane >> 4;
    const bf16_t* nat = (const bf16_t*)(p.ws + OFF_NAT);
    float* ga = (float*)(p.ws + OFF_ELAST);
    bf16_t* pt_out = (bf16_t*)(p.ws + OFF_PT);
    LAS bf16_t* Qs = (LAS bf16_t*)lds; LAS bf16_t* Ks = (LAS bf16_t*)(lds + 17408); LAS float* gl = (LAS float*)(lds + 34816);
    for (int unit = blockIdx.x; unit < NB * 4 * 257; unit += gridDim.x) {
        const int ci = unit % 257, r = unit / 257, h = r & 3, b = r >> 2;
        const int g0 = ci == 0 ? b * T : b * T + 16 + 64 * (ci - 1), c = ci == 0 ? 16 : 64;
#pragma unroll
        for (int i = 0; i < 2; ++i) { const int u = tid + 512 * i, row = u >> 4, oc = u & 15;
            u32x4 vq = (u32x4){0u, 0u, 0u, 0u}, vk = vq;
            if (row < c) { const bf16_t* rp = nat + (size_t)(g0 + row) * NAT0 + h * 128 + 8 * oc; vq = *(const u32x4*)(rp + C_QML); vk = *(const u32x4*)(rp + C_KML); }
            *(LAS u32x4*)(Qs + row * 136 + 8 * oc) = vq; *(LAS u32x4*)(Ks + row * 136 + 8 * oc) = vk; }
        if (w < 2) { const int dir = w; const bool valid = lane < c;
            float ig = -INFINITY, lf = 0.f;
            if (valid) { const bf16_t* gp = nat + (size_t)(g0 + lane) * NAT0 + C_GML;
                ig = bf1(gp[(2 * dir) * 4 + h]) + p.in[5][(2 * dir) * 4 + h];
                lf = log_sigmoid(bf1(gp[(2 * dir + 1) * 4 + h]) + p.in[5][(2 * dir + 1) * 4 + h]); }
            float bc = lf;
            if (dir == 0) {
#pragma unroll
                for (int o = 1; o < 64; o <<= 1) { const float t = sup(bc, o); if (lane >= o) bc += t; }
            } else {
#pragma unroll
                for (int o = 1; o < 64; o <<= 1) { const float t = sdown(bc, o); if (lane + o < 64) bc += t; }
            }
            const float a = valid ? ig - bc : -INFINITY;
            float rm = a;
            if (dir == 0) {
#pragma unroll
                for (int o = 1; o < 64; o <<= 1) { const float t = sup(rm, o); if (lane >= o) rm = fmaxf(rm, t); }
            } else {
#pragma unroll
                for (int o = 1; o < 64; o <<= 1) { const float t = sdown(rm, o); if (lane + o < 64) rm = fmaxf(rm, t); }
            }
            gl[dir * 128 + lane] = a; gl[dir * 128 + 64 + lane] = rm;
            if (valid) { const size_t o = (size_t)(dir * 4 + h) * MPAD + g0 + lane; ga[o] = a; ga[GA_STRIDE + o] = rm; ga[2 * GA_STRIDE + o] = bc; }
        }
        __syncthreads();
        {
            const int si = w & 3, tp = w >> 2;
            f32x4 a0 = (f32x4){0.f, 0.f, 0.f, 0.f}, a1 = a0;
#pragma unroll
            for (int kk = 0; kk < 4; ++kk) { const bf16x8 af = *(const LAS bf16x8*)(Ks + (16 * si + jq) * 136 + 32 * kk + 8 * q);
                a0 = mfma16(af, *(const LAS bf16x8*)(Qs + (16 * (2 * tp) + jq) * 136 + 32 * kk + 8 * q), a0);
                a1 = mfma16(af, *(const LAS bf16x8*)(Qs + (16 * (2 * tp + 1) + jq) * 136 + 32 * kk + 8 * q), a1); }
#pragma unroll
            for (int dir = 0; dir < 2; ++dir) {
                const f32x4 av4 = *(const LAS f32x4*)(gl + dir * 128 + 16 * si + 4 * q);
                bf16_t* po = pt_out + ((size_t)((dir * 4 + h) * 2 + b) * 257 + ci) * 4096;
#pragma unroll
                for (int tt = 0; tt < 2; ++tt) { const int t = 16 * (2 * tp + tt) + jq; const f32x4 a = tt == 0 ? a0 : a1; const float rmt = gl[dir * 128 + 64 + t]; float pv[4];
#pragma unroll
                    for (int rho = 0; rho < 4; ++rho) { const int s = 16 * si + 4 * q + rho;
                        const bool ok = (dir == 0 ? s <= t : s >= t) && s < c && t < c;
                        pv[rho] = ok ? __expf(av4[rho] - rmt) * a[rho] : 0.f; }
                    u32x2 wv2; wv2.x = pg8::cvt_pk_bf16(pv[0], pv[1]); wv2.y = pg8::cvt_pk_bf16(pv[2], pv[3]);
                    *(u32x2*)(po + t * 64 + 16 * si + 4 * q) = wv2; }
            }
        }
        __syncthreads();
    }
}
__device__ __forceinline__ void mlstm_scan(const Params& p, LAS unsigned char* lds, int idx, int wv) {
    const int tid = phase_tid(wv), lane = tid & 63, w = wv, jq = lane & 15, q = lane >> 4;
    const int sl = idx & 7, dir = (idx >> 3) & 1, h = (idx >> 4) & 3, b = idx >> 6;
    const bf16_t* nat = (const bf16_t*)(p.ws + OFF_NAT);
    const float* ga = (const float*)(p.ws + OFF_ELAST) + (size_t)(dir * 4 + h) * MPAD;
    const bf16_t* ptb = (const bf16_t*)(p.ws + OFF_PT) + (size_t)((dir * 4 + h) * 2 + b) * 257 * 4096;
    bf16_t* outp = (bf16_t*)(p.ws + OFF_HB) + (size_t)256 * DM + (size_t)dir * MPAD * 1024;
    constexpr int O_K = 17408, O_VT = 34816, O_VW = 39424, O_P = 46336, O_G = 55552, BUFB = 56064;
    constexpr int O_CT = 2 * BUFB, CTB = 48 * 136 * 2;
    LAS float* mch = (LAS float*)(lds + O_CT + 2 * CTB);
    LAS float* tmpf = mch + 260;
    for (int i = tid; i < 2 * CTB / 4; i += 512) ((LAS unsigned*)(lds + O_CT))[i] = 0u;
    for (int i = tid; i < 2 * 16 * 72 / 2; i += 512) { const int bb = i / (16 * 72 / 2), j = i % (16 * 72 / 2); ((LAS unsigned*)(lds + bb * BUFB + O_VW + 32 * 144))[j] = 0u; }
    if (tid < 257) { const int n = tid, ci = dir == 0 ? n : (n == 256 ? 0 : 256 - n);
        const int g0 = ci == 0 ? b * T : b * T + 16 + 64 * (ci - 1), c = ci == 0 ? 16 : 64;
        const int lastt = dir == 0 ? g0 + c - 1 : g0;
        tmpf[n] = ga[2 * GA_STRIDE + lastt]; tmpf[260 + n] = ga[GA_STRIDE + lastt]; }
    __syncthreads();
    if (tid == 0) { float m = 0.f; for (int n = 0; n < 257; ++n) { mch[n] = m; m = tmpf[n] + fmaxf(m, tmpf[260 + n]); } }
    f32x4 cst[3] = {(f32x4){0.f, 0.f, 0.f, 0.f}, (f32x4){0.f, 0.f, 0.f, 0.f}, (f32x4){0.f, 0.f, 0.f, 0.f}};
    u32x4 rq[2][2], rk[2][2], rv[2], rp[2]; float rg0[2], rg1[2], rg2[2], rgm[2];
    rv[0] = (u32x4){0u, 0u, 0u, 0u}; rv[1] = rv[0]; rg0[0] = rg0[1] = 0.f; rg1[0] = rg1[1] = 0.f; rg2[0] = rg2[1] = 0.f; rgm[0] = rgm[1] = 0.f;
#define ML_CHUNK(n_, g0_, c_, ci_) do { ci_ = dir == 0 ? (n_) : ((n_) == 256 ? 0 : 256 - (n_)); \
        if (ci_ == 0) { g0_ = b * T; c_ = 16; } else { g0_ = b * T + 16 + 64 * (ci_ - 1); c_ = 64; } } while (0)
#define ML_ISSUE(n_, S_) do { int g0i, ci_i, cix; ML_CHUNK(n_, g0i, ci_i, cix); \
        _Pragma("unroll") for (int i = 0; i < 2; ++i) { const int u = tid + 512 * i, row = u >> 4, oc = u & 15; \
            if (row < ci_i) { const bf16_t* rp_ = nat + (size_t)(g0i + row) * NAT0 + h * 128 + 8 * oc; rq[S_][i] = *(const u32x4*)(rp_ + C_QML); rk[S_][i] = *(const u32x4*)(rp_ + C_KML); } \
            else { rq[S_][i] = (u32x4){0u, 0u, 0u, 0u}; rk[S_][i] = rq[S_][i]; } } \
        rp[S_] = *(const u32x4*)(ptb + (size_t)cix * 4096 + 8 * tid); \
        if (tid < 256) { const int row = tid >> 2, pt = tid & 3; \
            if (row < ci_i) { rv[S_] = *(const u32x4*)(nat + (size_t)(g0i + row) * NAT0 + C_VML + h * 256 + sl * 32 + 8 * pt); rg0[S_] = ga[g0i + row]; } \
            else { rv[S_] = (u32x4){0u, 0u, 0u, 0u}; rg0[S_] = -INFINITY; } \
            rgm[S_] = ga[GA_STRIDE + (dir == 0 ? g0i + ci_i - 1 : g0i)]; } \
        if (tid < 64) { if (tid < ci_i) { rg1[S_] = ga[GA_STRIDE + g0i + tid]; rg2[S_] = ga[2 * GA_STRIDE + g0i + tid]; } else { rg1[S_] = -INFINITY; rg2[S_] = 0.f; } } } while (0)
#define ML_STAGE(n_, S_) do { LAS unsigned char* B_ = lds + ((n_) & 1) * BUFB; \
        _Pragma("unroll") for (int i = 0; i < 2; ++i) { const int u = tid + 512 * i, row = u >> 4, oc = u & 15; \
            *(LAS u32x4*)((LAS bf16_t*)B_ + row * 136 + 8 * oc) = rq[S_][i]; *(LAS u32x4*)((LAS bf16_t*)(B_ + O_K) + row * 136 + 8 * oc) = rk[S_][i]; } \
        *(LAS u32x4*)((LAS bf16_t*)(B_ + O_P) + (tid >> 3) * 72 + 8 * (tid & 7)) = rp[S_]; \
        if (tid < 256) { const int row = tid >> 2, pt = tid & 3; const float wt = __expf(rg0[S_] - fmaxf(mch[n_], rgm[S_])); \
            LAS bf16_t* vt_ = (LAS bf16_t*)(B_ + O_VT) + (8 * pt) * 72 + row; LAS bf16_t* vw_ = (LAS bf16_t*)(B_ + O_VW) + (8 * pt) * 72 + row; \
            const unsigned vv_[4] = {rv[S_].x, rv[S_].y, rv[S_].z, rv[S_].w}; \
            _Pragma("unroll") for (int e = 0; e < 4; ++e) { const unsigned ww_ = pg8::cvt_pk_bf16(bflo(vv_[e]) * wt, bfhi(vv_[e]) * wt); \
                vt_[(2 * e) * 72] = (bf16_t)(vv_[e] & 0xffffu); vt_[(2 * e + 1) * 72] = (bf16_t)(vv_[e] >> 16); \
                vw_[(2 * e) * 72] = (bf16_t)(ww_ & 0xffffu); vw_[(2 * e + 1) * 72] = (bf16_t)(ww_ >> 16); } \
            if (pt == 0) ((LAS bf16_t*)(B_ + O_VW))[32 * 72 + row] = (bf16_t)(pg8::cvt_pk_bf16(wt, wt) & 0xffffu); } \
        if (tid < 64) { LAS float* gv_ = (LAS float*)(B_ + O_G); gv_[tid] = rg1[S_]; gv_[64 + tid] = rg2[S_]; } } while (0)
#define ML_STEP(n_, P_) do { \
        int g0, c, ci; ML_CHUNK(n_, g0, c, ci); (void)ci; \
        LAS unsigned char* Bc = lds + (P_) * BUFB; \
        LAS bf16_t* Qs = (LAS bf16_t*)Bc; LAS bf16_t* Ks = (LAS bf16_t*)(Bc + O_K); LAS bf16_t* VT = (LAS bf16_t*)(Bc + O_VT); LAS bf16_t* VW = (LAS bf16_t*)(Bc + O_VW); \
        LAS bf16_t* Ps = (LAS bf16_t*)(Bc + O_P); LAS float* gv = (LAS float*)(Bc + O_G); \
        LAS bf16_t* CTc = (LAS bf16_t*)(lds + O_CT + (P_) * CTB); LAS bf16_t* CTn = (LAS bf16_t*)(lds + O_CT + ((P_) ^ 1) * CTB); \
        if ((n_) + 1 < 257) ML_STAGE((n_) + 1, (P_) ^ 1); \
        if ((n_) + 3 < 257) ML_ISSUE((n_) + 3, (P_) ^ 1); \
        const float m = mch[n_]; \
        const float mlast = fmaxf(m, dir == 0 ? gv[c - 1] : gv[0]); \
        const int oei = w & 1, oti = w >> 1; \
        { \
            f32x4 d1 = (f32x4){0.f, 0.f, 0.f, 0.f}, d2 = d1, dn = d1, dp = d1; \
            const bf16x8 ones = (bf16x8){0x3f80, 0x3f80, 0x3f80, 0x3f80, 0x3f80, 0x3f80, 0x3f80, 0x3f80}; \
        _Pragma("unroll") \
            for (int kk = 0; kk < 4; ++kk) { const bf16x8 qfr = *(const LAS bf16x8*)(Qs + (16 * oti + jq) * 136 + 32 * kk + 8 * q); \
                d1 = mfma16(*(const LAS bf16x8*)(CTc + (16 * oei + jq) * 136 + 32 * kk + 8 * q), qfr, d1); \
                dn = mfma16(*(const LAS bf16x8*)(CTc + 32 * 136 + 32 * kk + 8 * q), qfr, dn); } \
        _Pragma("unroll") \
            for (int ks = 0; ks < 2; ++ks) { const bf16x8 pfr = *(const LAS bf16x8*)(Ps + (16 * oti + jq) * 72 + 32 * ks + 8 * q); \
                d2 = mfma16(*(const LAS bf16x8*)(VT + (16 * oei + jq) * 72 + 32 * ks + 8 * q), pfr, d2); \
                dp = mfma16(ones, pfr, dp); } \
            const int t = 16 * oti + jq; \
            if (t < c) { const float rmt = gv[t], mtt = fmaxf(m, rmt); const float wp = __expf(m - mtt), rr = __expf(rmt - mtt), emt = __expf(-(gv[64 + t] + mtt)); \
                const float den = wp * dn[0] + rr * dp[0]; const float iv = __builtin_amdgcn_rcpf(fmaxf(fabsf(den), emt)); u32x2 wv2; \
                wv2.x = pg8::cvt_pk_bf16((wp * d1[0] + rr * d2[0]) * iv, (wp * d1[1] + rr * d2[1]) * iv); wv2.y = pg8::cvt_pk_bf16((wp * d1[2] + rr * d2[2]) * iv, (wp * d1[3] + rr * d2[3]) * iv); \
                *(u32x2*)(outp + (size_t)(g0 + t) * 1024 + h * 256 + sl * 32 + 16 * oei + 4 * q) = wv2; } \
        } \
        { const float wst = __expf(m - mlast); \
          f32x4 dacc[3] = {(f32x4){0.f, 0.f, 0.f, 0.f}, (f32x4){0.f, 0.f, 0.f, 0.f}, (f32x4){0.f, 0.f, 0.f, 0.f}}; \
        _Pragma("unroll") \
          for (int ks = 0; ks < 2; ++ks) { const bf16x8 af = gather8_tr(Ks, 32 * ks + 8 * q, 136, 16 * w, lane); \
        _Pragma("unroll") \
              for (int ej = 0; ej < 3; ++ej) dacc[ej] = mfma16(af, *(const LAS bf16x8*)(VW + (16 * ej + jq) * 72 + 32 * ks + 8 * q), dacc[ej]); } \
        _Pragma("unroll") \
          for (int ej = 0; ej < 3; ++ej) { cst[ej] = cst[ej] * wst + dacc[ej]; u32x2 wv2; wv2.x = pg8::cvt_pk_bf16(cst[ej][0], cst[ej][1]); wv2.y = pg8::cvt_pk_bf16(cst[ej][2], cst[ej][3]); \
              *(LAS u32x2*)(CTn + (16 * ej + jq) * 136 + 16 * w + 4 * q) = wv2; } } \
        BAR_LDS(); \
    } while (0)
    __syncthreads();
    ML_ISSUE(0, 0);
    ML_STAGE(0, 0);
    ML_ISSUE(1, 1);
    ML_ISSUE(2, 0);
    __syncthreads();
    for (int n = 0; n < 256; n += 2) { ML_STEP(n, 0); ML_STEP(n + 1, 1); }
    ML_STEP(256, 0);
    __syncthreads();
#undef ML_CHUNK
#undef ML_ISSUE
#undef ML_STAGE
#undef ML_STEP
}

__device__ __forceinline__ void post0_phase(const Params& p, int wv) {
    const int tid = phase_tid(wv), lane = tid & 63, wave = tid >> 6;
    const int gw = blockIdx.x * 8 + wave, NGW = gridDim.x * 8;
    const bf16_t* hf = (const bf16_t*)(p.ws + OFF_HB) + (size_t)256 * DM; const bf16_t* hbw = hf + (size_t)MPAD * 1024;
    const bf16_t* nat = (const bf16_t*)(p.ws + OFF_NAT);
    bf16_t* mix = (bf16_t*)(p.ws + OFF_MIX);
    for (int it = gw; it < M * 4; it += NGW) { const int g = it >> 2, hh = it & 3, col = hh * 256 + 4 * lane;
        const u32x2 a = *(const u32x2*)(hf + (size_t)g * 1024 + col), c = *(const u32x2*)(hbw + (size_t)g * 1024 + col), ov = *(const u32x2*)(nat + (size_t)g * NAT0 + C_OML + col);
        float v[4] = {bflo(a.x) + bflo(c.x), bfhi(a.x) + bfhi(c.x), bflo(a.y) + bflo(c.y), bfhi(a.y) + bfhi(c.y)};
        const float o[4] = {bflo(ov.x), bfhi(ov.x), bflo(ov.y), bfhi(ov.y)};
        const float s = wave_sum((v[0] * v[0] + v[1] * v[1]) + (v[2] * v[2] + v[3] * v[3]));
        const float rs = rsqrtf(s * (1.0f / 256.0f) + EPS); const f32x4 gn = *(const f32x4*)(p.in[9] + col);
#pragma unroll
        for (int e = 0; e < 4; ++e) v[e] = v[e] * rs * gn[e] * __builtin_amdgcn_rcpf(1.0f + __expf(-o[e]));
        u32x2 wv; wv.x = pk2(v[0], v[1]); wv.y = pk2(v[2], v[3]); *(u32x2*)(mix + (size_t)g * DM + 1024 + col) = wv; }
}

__device__ __forceinline__ void gla_pre(const Params& p, LAS unsigned char* lds, int wv) {
    const int tid = phase_tid(wv);
    bf16_t* nat = (bf16_t*)(p.ws + OFF_NAT);
    bf16_t* qb = (bf16_t*)(p.ws + OFF_W0); bf16_t* kb = qb + (size_t)MPAD * 1024;
    float* elast = (float*)(p.ws + OFF_ELAST);
    LAS bf16_t* qs = (LAS bf16_t*)lds; LAS bf16_t* ks = (LAS bf16_t*)(lds + 32768); LAS float* lrs = (LAS float*)(lds + 65536);
    for (int unit = blockIdx.x; unit < NB * 257 * 4; unit += gridDim.x) {
        const int h = unit & 3, ci = (unit >> 2) % 257, b = (unit >> 2) / 257;
        const int g0 = ci == 0 ? b * T : b * T + 16 + 64 * (ci - 1), c = ci == 0 ? 16 : 64;
#pragma unroll
        for (int i = 0; i < 4; ++i) { const int u = tid + 512 * i, row = u >> 5, oc = u & 31;
            u32x4 vq = (u32x4){0u, 0u, 0u, 0u}, vk = vq;
            if (row < c) { const bf16_t* rp = nat + (size_t)(g0 + row) * NAT1 + h * 256 + 8 * oc; vq = *(const u32x4*)(rp + C_GQ); vk = *(const u32x4*)(rp + C_GK); }
            *(LAS u32x4*)(qs + row * 256 + 8 * oc) = vq; *(LAS u32x4*)(ks + row * 256 + 8 * oc) = vk; }
        { const int row = tid >> 3, c4 = (tid & 7) * 4;
          if (row < c) { const u32x2 v = *(const u32x2*)(nat + (size_t)(g0 + row) * NAT1 + C_GLR + c4);
              lrs[row * 32 + c4] = bflo(v.x); lrs[row * 32 + c4 + 1] = bfhi(v.x); lrs[row * 32 + c4 + 2] = bflo(v.y); lrs[row * 32 + c4 + 3] = bfhi(v.y); } }
        __syncthreads();
        { const int d = tid & 255, dr = tid >> 8;
          float gu[16];
#pragma unroll
          for (int r = 0; r < 16; ++r) gu[r] = p.in[12][(size_t)(dr * 16 + r) * 1024 + h * 256 + d];
          const float gb = p.in[13][dr * 1024 + h * 256 + d];
          bf16_t* qo = dr == 0 ? nat + C_GQ : qb; bf16_t* ko = dr == 0 ? nat + C_GK : kb; const int ldo = dr == 0 ? NAT1 : 1024;
          float run = 0.f;
          for (int st = 0; st < c; ++st) { const int s = dr == 0 ? st : c - 1 - st;
              float x = gb;
#pragma unroll
              for (int r = 0; r < 16; ++r) x += lrs[s * 32 + dr * 16 + r] * gu[r];
              run += log_sigmoid(x) * (1.0f / 16.0f);
              const float E = __expf(run);
              const float qv = bf1(qs[s * 256 + d]) * E, kv = bf1(ks[s * 256 + d]) * __builtin_amdgcn_rcpf(E);
              qo[(size_t)(g0 + s) * ldo + h * 256 + d] = (bf16_t)f2bf(qv); ko[(size_t)(g0 + s) * ldo + h * 256 + d] = (bf16_t)f2bf(kv); }
          elast[((size_t)((dr * 2 + b) * 257 + ci) * 4 + h) * 256 + d] = __expf(run); }
        __syncthreads();
    }
}
__device__ __forceinline__ void gla_pre2(const Params& p, LAS unsigned char* lds, int wv) {
    const int tid = phase_tid(wv), lane = tid & 63, w = wv, jq = lane & 15, q = lane >> 4;
    const bf16_t* nat = (const bf16_t*)(p.ws + OFF_NAT);
    bf16_t* at_out = (bf16_t*)(p.ws + OFF_PT);
    LAS bf16_t* Qs = (LAS bf16_t*)lds; LAS bf16_t* Ks = (LAS bf16_t*)(lds + 33792);
    for (int unit = blockIdx.x; unit < 2 * NB * 257 * 4; unit += gridDim.x) {
        const int h = unit & 3, ci = (unit >> 2) % 257, r = (unit >> 2) / 257, b = r & 1, dir = r >> 1;
        const int g0 = ci == 0 ? b * T : b * T + 16 + 64 * (ci - 1), c = ci == 0 ? 16 : 64;
        const bf16_t* qsrc = dir == 0 ? nat + C_GQ : (const bf16_t*)(p.ws + OFF_W0);
        const bf16_t* ksrc = dir == 0 ? nat + C_GK : (const bf16_t*)(p.ws + OFF_W0) + (size_t)MPAD * 1024;
        const int ldq = dir == 0 ? NAT1 : 1024;
#pragma unroll
        for (int i = 0; i < 4; ++i) { const int u = tid + 512 * i, row = u >> 5, oc = u & 31;
            u32x4 vq = (u32x4){0u, 0u, 0u, 0u}, vk = vq;
            if (row < c) { const size_t off = (size_t)(g0 + row) * ldq + h * 256 + 8 * oc; vq = *(const u32x4*)(qsrc + off); vk = *(const u32x4*)(ksrc + off); }
            *(LAS u32x4*)(Qs + row * 264 + 8 * oc) = vq; *(LAS u32x4*)(Ks + row * 264 + 8 * oc) = vk; }
        __syncthreads();
        {
            const int si = w & 3, tp = w >> 2;
            f32x4 a0 = (f32x4){0.f, 0.f, 0.f, 0.f}, a1 = a0;
#pragma unroll
            for (int kk = 0; kk < 8; ++kk) { const bf16x8 af = *(const LAS bf16x8*)(Ks + (16 * si + jq) * 264 + 32 * kk + 8 * q);
                a0 = mfma16(af, *(const LAS bf16x8*)(Qs + (16 * (2 * tp) + jq) * 264 + 32 * kk + 8 * q), a0);
                a1 = mfma16(af, *(const LAS bf16x8*)(Qs + (16 * (2 * tp + 1) + jq) * 264 + 32 * kk + 8 * q), a1); }
            bf16_t* po = at_out + (size_t)unit * 4096;
#pragma unroll
            for (int tt = 0; tt < 2; ++tt) { const int t = 16 * (2 * tp + tt) + jq; const f32x4 a = tt == 0 ? a0 : a1; float pv[4];
#pragma unroll
                for (int rho = 0; rho < 4; ++rho) { const int s = 16 * si + 4 * q + rho;
                    const bool ok = (dir == 0 ? s <= t : s >= t) && s < c && t < c; pv[rho] = ok ? a[rho] : 0.f; }
                u32x2 wv2; wv2.x = pg8::cvt_pk_bf16(pv[0], pv[1]); wv2.y = pg8::cvt_pk_bf16(pv[2], pv[3]);
                *(u32x2*)(po + t * 64 + 16 * si + 4 * q) = wv2; }
        }
        __syncthreads();
    }
}
__device__ __forceinline__ void gla_scan(const Params& p, LAS unsigned char* lds, int idx, int wv) {
    const int tid = phase_tid(wv), lane = tid & 63, w = wv, jq = lane & 15, q = lane >> 4;
    const int sl = idx & 15, dir = (idx >> 4) & 1, h = (idx >> 5) & 3, b = idx >> 7;
    const bf16_t* nat = (const bf16_t*)(p.ws + OFF_NAT);
    const bf16_t* qsrc = dir == 0 ? nat + C_GQ : (const bf16_t*)(p.ws + OFF_W0);
    const bf16_t* ksrc = dir == 0 ? nat + C_GK : (const bf16_t*)(p.ws + OFF_W0) + (size_t)MPAD * 1024;
    const int lds_ = dir == 0 ? NAT1 : 1024;
    const float* elast = (const float*)(p.ws + OFF_ELAST);
    const bf16_t* atb = (const bf16_t*)(p.ws + OFF_PT);
    bf16_t* outp = dir == 0 ? (bf16_t*)(p.ws + OFF_HB) + (size_t)256 * DM : (bf16_t*)(p.ws + OFF_MIX);
    constexpr int O_VT = 33792, O_A = 38400, O_EL = 47616, BUFB = 48640;
    constexpr int O_ST = 2 * BUFB, STB = 32 * 264 * 2;
    for (int i = tid; i < 2 * STB / 4; i += 512) ((LAS unsigned*)(lds + O_ST))[i] = 0u;
    f32x4 sst[4][2];
#pragma unroll
    for (int a = 0; a < 4; ++a)
#pragma unroll
        for (int e = 0; e < 2; ++e) sst[a][e] = (f32x4){0.f, 0.f, 0.f, 0.f};
    const bool owave = w >= 4; const int oti = w & 3;
    u32x4 rk[2][4], rv[2], ra[2]; float rel[2];
    bf16x8 qn[2][8];
    rv[0] = (u32x4){0u, 0u, 0u, 0u}; rv[1] = rv[0]; rel[0] = 0.f; rel[1] = 0.f;
#define GLA_CHUNK(n_, g0_, c_, ci_) do { ci_ = dir == 0 ? (n_) : ((n_) == 256 ? 0 : 256 - (n_)); \
        if (ci_ == 0) { g0_ = b * T; c_ = 16; } else { g0_ = b * T + 16 + 64 * (ci_ - 1); c_ = 64; } } while (0)
#define GLA_ISSUE(n_, S_) do { int g0i, ci_i, cci; GLA_CHUNK(n_, g0i, ci_i, cci); \
        _Pragma("unroll") for (int i = 0; i < 4; ++i) { const int u = tid + 512 * i, row = u >> 5, oc = u & 31; \
            if (row < ci_i) rk[S_][i] = *(const u32x4*)(ksrc + (size_t)(g0i + row) * lds_ + h * 256 + 8 * oc); else rk[S_][i] = (u32x4){0u, 0u, 0u, 0u}; } \
        ra[S_] = *(const u32x4*)(atb + ((size_t)(((dir * 2 + b) * 257 + cci) * 4 + h)) * 4096 + 8 * tid); \
        if (tid < 256) { const int row = tid >> 2, pt = tid & 3; \
            rv[S_] = row < ci_i ? *(const u32x4*)(nat + (size_t)(g0i + row) * NAT1 + C_GV + h * 512 + sl * 32 + 8 * pt) : (u32x4){0u, 0u, 0u, 0u}; \
            rel[S_] = elast[((size_t)((dir * 2 + b) * 257 + cci) * 4 + h) * 256 + tid]; } } while (0)
#define GLA_QISSUE(n_, S_) do { if (owave) { int g0i, ci_i, cci; GLA_CHUNK(n_, g0i, ci_i, cci); (void)ci_i; (void)cci; \
        const bf16_t* qp_ = qsrc + (size_t)(g0i + 16 * oti + jq) * lds_ + h * 256 + 8 * q; \
        _Pragma("unroll") for (int kk = 0; kk < 8; ++kk) qn[S_][kk] = *(const bf16x8*)(qp_ + 32 * kk); } } while (0)
#define GLA_STAGE(n_, S_) do { LAS unsigned char* B_ = lds + ((n_) & 1) * BUFB; \
        _Pragma("unroll") for (int i = 0; i < 4; ++i) { const int u = tid + 512 * i, row = u >> 5, oc = u & 31; *(LAS u32x4*)((LAS bf16_t*)B_ + row * 264 + 8 * oc) = rk[S_][i]; } \
        *(LAS u32x4*)((LAS bf16_t*)(B_ + O_A) + (tid >> 3) * 72 + 8 * (tid & 7)) = ra[S_]; \
        if (tid < 256) { const int row = tid >> 2, pt = tid & 3; LAS bf16_t* vt_ = (LAS bf16_t*)(B_ + O_VT) + (8 * pt) * 72 + row; \
            const unsigned vv_[4] = {rv[S_].x, rv[S_].y, rv[S_].z, rv[S_].w}; \
            _Pragma("unroll") for (int e = 0; e < 4; ++e) { vt_[(2 * e) * 72] = (bf16_t)(vv_[e] & 0xffffu); vt_[(2 * e + 1) * 72] = (bf16_t)(vv_[e] >> 16); } \
            ((LAS float*)(B_ + O_EL))[tid] = rel[S_]; } } while (0)
#define GLA_STEP(n_, P_) do { \
        int g0, c, ci; GLA_CHUNK(n_, g0, c, ci); (void)ci; \
        LAS unsigned char* Bc = lds + (P_) * BUFB; \
        LAS bf16_t* Ks = (LAS bf16_t*)Bc; LAS bf16_t* VT = (LAS bf16_t*)(Bc + O_VT); LAS bf16_t* As = (LAS bf16_t*)(Bc + O_A); LAS float* el = (LAS float*)(Bc + O_EL); \
        LAS bf16_t* STc = (LAS bf16_t*)(lds + O_ST + (P_) * STB); LAS bf16_t* STn = (LAS bf16_t*)(lds + O_ST + ((P_) ^ 1) * STB); \
        if ((n_) + 1 < 257) GLA_STAGE((n_) + 1, (P_) ^ 1); \
        if ((n_) + 3 < 257) GLA_ISSUE((n_) + 3, (P_) ^ 1); \
        if (owave) { \
            f32x4 oa0 = (f32x4){0.f, 0.f, 0.f, 0.f}, oa1 = oa0; \
            _Pragma("unroll") for (int kk = 0; kk < 8; ++kk) { \
                oa0 = mfma16(*(const LAS bf16x8*)(STc + (jq) * 264 + 32 * kk + 8 * q), qn[P_][kk], oa0); \
                oa1 = mfma16(*(const LAS bf16x8*)(STc + (16 + jq) * 264 + 32 * kk + 8 * q), qn[P_][kk], oa1); } \
            if ((n_) + 2 < 257) GLA_QISSUE((n_) + 2, P_); \
            _Pragma("unroll") for (int ks = 0; ks < 2; ++ks) { const bf16x8 afr = *(const LAS bf16x8*)(As + (16 * oti + jq) * 72 + 32 * ks + 8 * q); \
                oa0 = mfma16(*(const LAS bf16x8*)(VT + (jq) * 72 + 32 * ks + 8 * q), afr, oa0); \
                oa1 = mfma16(*(const LAS bf16x8*)(VT + (16 + jq) * 72 + 32 * ks + 8 * q), afr, oa1); } \
            const int t = 16 * oti + jq; \
            if (t < c) { bf16_t* op_ = outp + (size_t)(g0 + t) * DM + h * 512 + sl * 32 + 4 * q; \
                u32x2 wa; wa.x = pg8::cvt_pk_bf16(oa0[0], oa0[1]); wa.y = pg8::cvt_pk_bf16(oa0[2], oa0[3]); *(u32x2*)(op_) = wa; \
                u32x2 wb; wb.x = pg8::cvt_pk_bf16(oa1[0], oa1[1]); wb.y = pg8::cvt_pk_bf16(oa1[2], oa1[3]); *(u32x2*)(op_ + 16) = wb; } \
        } else { \
            bf16x8 vf[2][2]; \
            _Pragma("unroll") for (int ks = 0; ks < 2; ++ks) \
                _Pragma("unroll") for (int ej = 0; ej < 2; ++ej) vf[ks][ej] = *(const LAS bf16x8*)(VT + (16 * ej + jq) * 72 + 32 * ks + 8 * q); \
            _Pragma("unroll") for (int dd = 0; dd < 4; ++dd) { \
                f32x4 dl0 = (f32x4){0.f, 0.f, 0.f, 0.f}, dl1 = dl0; \
                _Pragma("unroll") for (int ks = 0; ks < 2; ++ks) { const bf16x8 af = gather8_tr(Ks, 32 * ks + 8 * q, 264, 16 * (4 * w + dd), lane); \
                    dl0 = mfma16(af, vf[ks][0], dl0); dl1 = mfma16(af, vf[ks][1], dl1); } \
                const int d0 = 16 * (4 * w + dd) + 4 * q; const f32x4 ev = *(const LAS f32x4*)(el + d0); \
                sst[dd][0] = (sst[dd][0] + dl0) * ev; sst[dd][1] = (sst[dd][1] + dl1) * ev; \
                u32x2 w0; w0.x = pg8::cvt_pk_bf16(sst[dd][0][0], sst[dd][0][1]); w0.y = pg8::cvt_pk_bf16(sst[dd][0][2], sst[dd][0][3]); \
                u32x2 w1; w1.x = pg8::cvt_pk_bf16(sst[dd][1][0], sst[dd][1][1]); w1.y = pg8::cvt_pk_bf16(sst[dd][1][2], sst[dd][1][3]); \
                *(LAS u32x2*)(STn + (0 + jq) * 264 + d0) = w0; *(LAS u32x2*)(STn + (16 + jq) * 264 + d0) = w1; \
            } \
        } \
        BAR_LDS(); } while (0)
    __syncthreads();
    GLA_ISSUE(0, 0);
    GLA_STAGE(0, 0);
    GLA_ISSUE(1, 1);
    GLA_ISSUE(2, 0);
    GLA_QISSUE(0, 0);
    GLA_QISSUE(1, 1);
    __syncthreads();
    for (int n = 0; n < 256; n += 2) { GLA_STEP(n, 0); GLA_STEP(n + 1, 1); }
    GLA_STEP(256, 0);
    __syncthreads();
#undef GLA_CHUNK
#undef GLA_ISSUE
#undef GLA_QISSUE
#undef GLA_STAGE
#undef GLA_STEP
}
__device__ __forceinline__ void post1_phase(const Params& p, int wv) {
    const int tid = phase_tid(wv), lane = tid & 63, wave = tid >> 6;
    const int gw = blockIdx.x * 8 + wave, NGW = gridDim.x * 8;
    const bf16_t* of = (const bf16_t*)(p.ws + OFF_HB) + (size_t)256 * DM;
    bf16_t* mix = (bf16_t*)(p.ws + OFF_MIX);
    const bf16_t* nat = (const bf16_t*)(p.ws + OFF_NAT);
    for (int it = gw; it < M * 4; it += NGW) { const int g = it >> 2, hh = it & 3, col = hh * 512 + 8 * lane;
        const u32x4 a = *(const u32x4*)(of + (size_t)g * DM + col), c = *(const u32x4*)(mix + (size_t)g * DM + col), rv = *(const u32x4*)(nat + (size_t)g * NAT1 + C_GR + col);
        float v[8] = {bflo(a.x) + bflo(c.x), bfhi(a.x) + bfhi(c.x), bflo(a.y) + bflo(c.y), bfhi(a.y) + bfhi(c.y), bflo(a.z) + bflo(c.z), bfhi(a.z) + bfhi(c.z), bflo(a.w) + bflo(c.w), bfhi(a.w) + bfhi(c.w)};
        const float r[8] = {bflo(rv.x), bfhi(rv.x), bflo(rv.y), bfhi(rv.y), bflo(rv.z), bfhi(rv.z), bflo(rv.w), bfhi(rv.w)};
        float s = 0.f;
#pragma unroll
        for (int e = 0; e < 8; ++e) s += v[e] * v[e];
        s = wave_sum(s);
        const float rs = rsqrtf(s * (1.0f / 512.0f) + EPS);
        const float* gn = p.in[14] + col;
#pragma unroll
        for (int e = 0; e < 8; ++e) v[e] = v[e] * rs * gn[e] * r[e] * __builtin_amdgcn_rcpf(1.0f + __expf(-r[e]));
        u32x4 wv; wv.x = pk2(v[0], v[1]); wv.y = pk2(v[2], v[3]); wv.z = pk2(v[4], v[5]); wv.w = pk2(v[6], v[7]);
        *(u32x4*)(mix + (size_t)g * DM + col) = wv; }
}

__device__ __forceinline__ void tail_rows(LAS unsigned char* lds, const bf16_t* A, const bf16_t* Bt, int K, const pg8::EpiRes& E, int wv) {
    const int lane = lane_id_v(), jq = lane & 15, q = lane >> 4;
    LAS float* red = (LAS float*)lds;
    for (int j = blockIdx.x; j < 256; j += gridDim.x) {
        const int rt = j >> 7, ct = j & 127, g = 32768 + 16 * rt + jq, kw = K >> 3, k0 = wv * kw;
        const bf16_t* ap = A + (size_t)g * K + k0 + 8 * q; const bf16_t* bp = Bt + (size_t)(16 * ct + jq) * K + k0 + 8 * q;
        f32x4 acc = (f32x4){0.f, 0.f, 0.f, 0.f};
#pragma unroll 4
        for (int k = 0; k < kw; k += 32) acc = mfma16(*(const bf16x8*)(bp + k), *(const bf16x8*)(ap + k), acc);
        *(LAS f32x4*)(red + (wv * 64 + lane) * 4) = acc;
        __syncthreads();
        if (wv == 0) {
            f32x4 v = (f32x4){0.f, 0.f, 0.f, 0.f};
#pragma unroll
            for (int i = 0; i < 8; ++i) v += *(const LAS f32x4*)(red + (i * 64 + lane) * 4);
            const int b = 1, t = g - T, col = 16 * ct + 4 * q;
            const float* sp = E.srcx + ((size_t)b * SEQ + (t - 16)) * DM; float* dp = E.dstx + ((size_t)b * SEQ + (t - 16)) * DM;
            v += *(const f32x4*)(sp + col);
            *(f32x4*)(dp + col) = v;
            if (E.hb) { u32x2 w2; w2.x = pg8::cvt_pk_bf16(v[0], v[1]); w2.y = pg8::cvt_pk_bf16(v[2], v[3]); *(u32x2*)(E.hb + (size_t)g * DM + col) = w2; }
            float ss = (v[0] * v[0] + v[1] * v[1]) + (v[2] * v[2] + v[3] * v[3]);
            ss += sxor(ss, 16); ss += sxor(ss, 32);
            if (E.ssq && q == 0) atomicAdd(E.ssq + g, ss);
        }
        __syncthreads();
    }
}

constexpr size_t OFF_XBAR = 16 * 1024;
constexpr int LDS_XBST = LDS_BYTES - 16;
#define XB_TMO      128
#define XB_XCNT(j)  (256  + 64 * (j))
#define XB_XSUB(j)  (1280 + 64 * (j))
#define XB_XGEN(j)  (2304 + 64 * (j))
#define XB_TOP      3328
#define XB_TOPGEN   3392
#define XCD_BAR_WORDS 3456
#define XB_SPIN_CAP (1u << 18)

__device__ __forceinline__ unsigned xb_ld(unsigned* p)              { return __hip_atomic_load(p, __ATOMIC_RELAXED, __HIP_MEMORY_SCOPE_AGENT); }
__device__ __forceinline__ unsigned xb_add(unsigned* p, unsigned v) { return __hip_atomic_fetch_add(p, v, __ATOMIC_RELAXED, __HIP_MEMORY_SCOPE_AGENT); }
__device__ __forceinline__ unsigned xb_xcc_id() { return (unsigned)__builtin_amdgcn_s_getreg((3 << 11) | 20) & 0xFu; }
#define XB_SPIN(cond, bar) do { unsigned _sp = 0; while (cond) { __builtin_amdgcn_s_sleep(1); \
    if ((++_sp & 255u) == 0u) { if (xb_ld(&(bar)[XB_TMO])) break; if (_sp > XB_SPIN_CAP) { atomicAdd(&(bar)[XB_TMO], 1u); break; } } } } while (0)

struct XcdBarrier {
    unsigned* bar; unsigned x;
    volatile LAS unsigned* st;
};

__device__ __forceinline__ XcdBarrier xcd_barrier_post(unsigned* bar, volatile LAS unsigned* st) {
    XcdBarrier b; b.bar = bar; b.x = xb_xcc_id(); b.st = st;
    if (threadIdx.x == 0) (void)xb_add(&bar[XB_XCNT(b.x)], 1u);
    return b;
}
__device__ __forceinline__ void xcd_barrier_complete(unsigned* bar, unsigned x, unsigned& nloc, unsigned& nx) {
    const unsigned G = gridDim.x * gridDim.y * gridDim.z;
    unsigned sum, cnt, mine, sp = 0u;
    for (;;) {
        sum = 0u; cnt = 0u; mine = 0u;
#pragma unroll
        for (unsigned j = 0; j < 16; ++j) { const unsigned c = xb_ld(&bar[XB_XCNT(j)]); sum += c; cnt += (c > 0u) ? 1u : 0u; mine = (j == x) ? c : mine; }
        if (sum == G) break;
        __builtin_amdgcn_s_sleep(1);
        if ((++sp & 255u) == 0u) { if (xb_ld(&bar[XB_TMO])) break; if (sp > XB_SPIN_CAP) { atomicAdd(&bar[XB_TMO], 1u); break; } }
    }
    nloc = mine > 0u ? mine : 1u; nx = cnt > 0u ? cnt : 1u;
}

__device__ __forceinline__ void xcd_barrier(const XcdBarrier& b) {
    asm volatile("s_waitcnt vmcnt(0)" ::: "memory");
    __syncthreads();
    if (threadIdx.x == 0) {
        unsigned* bar = b.bar;
        __builtin_amdgcn_s_waitcnt(0);
        unsigned nloc = b.st[0], nx = b.st[1];
        if (nloc == 0u) { xcd_barrier_complete(bar, b.x, nloc, nx); b.st[0] = nloc; b.st[1] = nx; }
        const unsigned old = xb_add(&bar[XB_XSUB(b.x)], 1u);
        const unsigned gen = old / nloc;
        if (old + 1u == (gen + 1u) * nloc) {
            __builtin_amdgcn_fence(__ATOMIC_RELEASE, "agent");
            asm volatile("s_waitcnt vmcnt(0)" ::: "memory");
            const unsigned og = xb_add(&bar[XB_TOP], 1u);
            const unsigned tg = og / nx;
            if (og + 1u == (tg + 1u) * nx) xb_add(&bar[XB_TOPGEN], 1u);
            else XB_SPIN(xb_ld(&bar[XB_TOPGEN]) == tg, bar);
            __builtin_amdgcn_fence(__ATOMIC_ACQUIRE, "agent");
            xb_add(&bar[XB_XGEN(b.x)], 1u);
            asm volatile("s_waitcnt vmcnt(0)" ::: "memory");
        } else {
            XB_SPIN(xb_ld(&bar[XB_XGEN(b.x)]) == gen, bar);
            __builtin_amdgcn_fence(__ATOMIC_ACQUIRE, "agent");
            asm volatile("s_waitcnt vmcnt(0)" ::: "memory");
        }
    }
    __syncthreads();
}

__global__ void __launch_bounds__(512, 2) fwd_megakernel(Params p) {
    extern __shared__ __attribute__((aligned(16))) unsigned char lds_raw[];
    LAS unsigned char* lds = (LAS unsigned char*)lds_raw;
    cg::grid_group grid = cg::this_grid();
    const int wv = __builtin_amdgcn_readfirstlane((int)(threadIdx.x >> 6));
    if (threadIdx.x < 2) ((LAS unsigned*)(lds + LDS_XBST))[threadIdx.x] = 0u;
    __syncthreads();
    const XcdBarrier xbar = xcd_barrier_post((unsigned*)(p.ws + OFF_CTL + OFF_XBAR), (volatile LAS unsigned*)(lds + LDS_XBST));
    unsigned char* ws = p.ws;
    const int G = gridDim.x, bx = blockIdx.x;
    bf16_t* hb = (bf16_t*)(ws + OFF_HB) + (size_t)256 * DM;
    bf16_t* nat = (bf16_t*)(ws + OFF_NAT);
    bf16_t* act = (bf16_t*)(ws + OFF_NAT);
    bf16_t* mix = (bf16_t*)(ws + OFF_MIX);
    float* ssq = (float*)(ws + OFF_SSQ);
    float* hmeta = (float*)(ws + OFF_HMETA);
    unsigned* ctr = (unsigned*)(ws + OFF_CTL);
    LAS float* xl = (LAS float*)(lds + LDS_XCH);

    p0_prologue(p, lds, wv);
    grid.sync();
    { pg8::Gemm g{hb, (const bf16_t*)(ws + OFF_W0 + W_NAT0), DM}; pg8::Order S; S.init(NMT, NAT0 / 256, G, bx, 0);
      pg8::EpiScale E{nat, NAT0, ssq}; pg8::gemm_phase(lds, g, S, E, wv); }
    { pg8::Gemm g{(const bf16_t*)(ws + OFF_W0 + W_TR0), hb, DM}; pg8::Order S; S.init(4, NMT, G, bx, 0);
      pg8::EpiScaleT E{(bf16_t*)(ws + OFF_TR), ssq}; pg8::gemm_phase(lds, g, S, E, wv); }
    xcd_barrier(xbar);
    qknorm_phase(p, wv);
    ml_pre(p, lds, wv);
    xcd_barrier(xbar);
#ifndef NO_ML
    for (int idx = bx; idx < 128; idx += G) mlstm_scan(p, lds, G == 256 ? ((idx & 7) * 16 + (idx >> 3)) : idx, wv);
#endif
#ifndef NO_NA
    na_phase(p, lds, ctr, wv);
#endif
    xcd_barrier(xbar);
    post0_phase(p, wv);
    xcd_barrier(xbar);
    { pg8::Gemm g{mix, (const bf16_t*)(ws + OFF_W0 + W_OUT0), DM}; pg8::Order S; S.init(NMT - 1, 8, G, bx, 0);
      pg8::EpiRes E{p.in[0], hmeta, p.out, hmeta, hb, ssq + MPAD}; tail_rows(lds, g.A, g.Bt, g.K, E, wv); pg8::gemm_phase(lds, g, S, E, wv); }
    xcd_barrier(xbar);
    { pg8::Gemm g{hb, (const bf16_t*)(ws + OFF_W0 + W_UP0), DM}; pg8::Order S; S.init(130, 44, G, bx, 1);
      pg8::EpiFfn E{act, ssq + MPAD, p.in[17], p.in[18], xl};
#ifndef NO_FFN
      pg8::gemm_phase(lds, g, S, E, wv);
#endif
    }
    xcd_barrier(xbar);
    { pg8::Gemm g{act, (const bf16_t*)(ws + OFF_W0 + W_DN0), FF}; pg8::Order S; S.init(NMT - 1, 8, G, bx, 0);
      pg8::EpiRes E{p.out, hmeta, p.out, hmeta, hb, ssq + 2 * MPAD}; tail_rows(lds, g.A, g.Bt, g.K, E, wv); pg8::gemm_phase(lds, g, S, E, wv); }
    xcd_barrier(xbar);
    { pg8::Gemm g{hb, (const bf16_t*)(ws + OFF_W1 + W_NAT1), DM}; pg8::Order S; S.init(NMT, NAT1 / 256, G, bx, 0);
      pg8::EpiScale E{nat, NAT1, ssq + 2 * MPAD}; pg8::gemm_phase(lds, g, S, E, wv); }
    xcd_barrier(xbar);
#ifndef NO_GP
    gla_pre(p, lds, wv);
#endif
    xcd_barrier(xbar);
    gla_pre2(p, lds, wv);
    xcd_barrier(xbar);
#ifndef NO_GS
    for (int idx = bx; idx < 256; idx += G) gla_scan(p, lds, G == 256 ? ((idx & 7) * 32 + (idx >> 3)) : idx, wv);
#endif
    xcd_barrier(xbar);
    post1_phase(p, wv);
    xcd_barrier(xbar);
    { pg8::Gemm g{mix, (const bf16_t*)(ws + OFF_W1 + W_OUT1), DM}; pg8::Order S; S.init(NMT - 1, 8, G, bx, 0);
      pg8::EpiRes E{p.out, hmeta, p.out, hmeta, hb, ssq + 3 * MPAD}; tail_rows(lds, g.A, g.Bt, g.K, E, wv); pg8::gemm_phase(lds, g, S, E, wv); }
    xcd_barrier(xbar);
    { pg8::Gemm g{hb, (const bf16_t*)(ws + OFF_W1 + W_UP1), DM}; pg8::Order S; S.init(130, 44, G, bx, 1);
      pg8::EpiFfn E{act, ssq + 3 * MPAD, p.in[17] + 3 * FF2, p.in[18] + FF2, xl};
#ifndef NO_FFN
      pg8::gemm_phase(lds, g, S, E, wv);
#endif
    }
    xcd_barrier(xbar);
    { pg8::Gemm g{act, (const bf16_t*)(ws + OFF_W1 + W_DN1), FF}; pg8::Order S; S.init(NMT - 1, 8, G, bx, 0);
      pg8::EpiRes E{p.out, hmeta, p.out, (float*)nullptr, (bf16_t*)nullptr, (float*)nullptr}; tail_rows(lds, g.A, g.Bt, g.K, E, wv); pg8::gemm_phase(lds, g, S, E, wv); }
}

extern "C" void kernel_launch(void* const* d_in, const int* in_sizes, int n_in, void* d_out, int out_size, void* d_ws, size_t ws_size, hipStream_t stream) {
    static int grid_blocks = 0;
    if (grid_blocks == 0) {
        if (n_in != 20 || ws_size < WS_NEED) { fprintf(stderr, "kernel_launch: need 20 inputs and %zu bytes of workspace (got %d, %zu)\n", (size_t)WS_NEED, n_in, ws_size); grid_blocks = -1; return; }
        int dev = 0, cus = 0, per_cu = 0;
        hipGetDevice(&dev);
        hipDeviceGetAttribute(&cus, hipDeviceAttributeMultiprocessorCount, dev);
        if (hipFuncSetAttribute((const void*)fwd_megakernel, hipFuncAttributeMaxDynamicSharedMemorySize, LDS_BYTES) != hipSuccess) { fprintf(stderr, "kernel_launch: hipFuncSetAttribute failed\n"); }
        hipOccupancyMaxActiveBlocksPerMultiprocessor(&per_cu, (const void*)fwd_megakernel, 512, LDS_BYTES);
        if (per_cu < 1) { fprintf(stderr, "kernel_launch: occupancy query returned %d\n", per_cu); per_cu = 1; }
        (void)hipGetLastError();
        grid_blocks = cus * per_cu;
    }
    if (grid_blocks < 0) return;
    hipMemsetAsync((char*)d_ws + OFF_CTL, 0, CTL_BYTES, stream);
    Params p{};
    for (int i = 0; i < 20; ++i) p.in[i] = (const float*)d_in[i];
    p.out = (float*)d_out; p.ws = (unsigned char*)d_ws;
    void* args[] = {&p};
    hipError_t e = hipLaunchCooperativeKernel((const void*)fwd_megakernel, dim3(grid_blocks), dim3(512), args, LDS_BYTES, stream);
    if (e != hipSuccess) fprintf(stderr, "cooperative launch failed: %s (grid %d)\n", hipGetErrorString(e), grid_blocks);
}
```
